# Optimizing an MI355X kernel written in HIP

```python
import math
import jax, jax.numpy as jnp
from jax import lax
import numpy as np

D_MODEL = 1024
BATCH = 16
SEQ = 2048
DEPTH = 1

N_DIFF_HEADS = 8
DIFF_HEAD_DIM = 64
ATTN_WIDTH = N_DIFF_HEADS * 2 * DIFF_HEAD_DIM
Q_BLOCK = 128
SGU_WIDTH = 1024
N_SGU_GROUPS = 8
SGU_GROUP_DIM = SGU_WIDTH // N_SGU_GROUPS
SGU_CHUNK = 128
N_GROUPS = 4
EXPERTS_PER_GROUP = 8
N_EXPERTS = N_GROUPS * EXPERTS_PER_GROUP
TOP_K_IN_GROUP = 2
D_EXPERT = 256
IN_SIZES = [ATTN_WIDTH, ATTN_WIDTH, ATTN_WIDTH, SGU_WIDTH, SGU_WIDTH, D_MODEL, D_MODEL]
IN_WIDTH = sum(IN_SIZES)
IN_SPLITS = [int(v) for v in np.cumsum(IN_SIZES)[:-1]]
EPS = 1e-6
ALIBI_SLOPES = np.array([2.0 ** (-8.0 * (h + 1) / N_DIFF_HEADS) for h in range(N_DIFF_HEADS)], dtype=np.float32)

kernel_name = "hybrid_diffattn_sgu_hmoe_encoder"


def lambda_init_fn(layer):
    return 0.8 - 0.6 * math.exp(-0.3 * layer)


def rmsnorm(x, g):
    xf = x.astype(jnp.float32)
    y = xf * lax.rsqrt(jnp.mean(xf * xf, axis=-1, keepdims=True) + EPS)
    return y.astype(x.dtype) * g


def layernorm(x, g, b):
    xf = x.astype(jnp.float32)
    mu = jnp.mean(xf, axis=-1, keepdims=True)
    var = jnp.mean(jnp.square(xf - mu), axis=-1, keepdims=True)
    return ((xf - mu) * lax.rsqrt(var + EPS)).astype(x.dtype) * g + b


def modulate(h, shift, scale):
    return h * (1.0 + scale[:, None, :]) + shift[:, None, :]


def diff_attention(q, k, v, lam, sub_g, lam_init):
    B, S = q.shape[0], q.shape[1]
    scale = DIFF_HEAD_DIM ** -0.5
    slopes = jnp.asarray(ALIBI_SLOPES)
    kpos = jnp.arange(S)

    def block(i):
        start = i * Q_BLOCK
        qb = lax.dynamic_slice_in_dim(q, start, Q_BLOCK, axis=1)
        qpos = start + jnp.arange(Q_BLOCK)
        dist = jnp.abs(qpos[:, None] - kpos[None, :]).astype(jnp.float32)
        bias = -slopes[:, None, None, None] * dist[None, None]
        s = jnp.einsum('bqhmd,bkhmd->bhmqk', qb, k).astype(jnp.float32) * scale + bias
        p = jax.nn.softmax(s, axis=-1)
        a = p[:, :, 0] - lam * p[:, :, 1]
        return jnp.einsum('bhqk,bkhe->bqhe', a.astype(v.dtype), v)

    out = lax.map(block, jnp.arange(S // Q_BLOCK))
    out = jnp.moveaxis(out, 0, 1).reshape(B, S, N_DIFF_HEADS, 2 * DIFF_HEAD_DIM)
    out = rmsnorm(out, sub_g) * (1.0 - lam_init)
    return out.reshape(B, S, ATTN_WIDTH)


def spatial_gating(u, s, ln_g, ln_b, w_s, b_s):
    B, S = u.shape[0], u.shape[1]
    v = layernorm(s, ln_g, ln_b)
    v = v.reshape(B, S // SGU_CHUNK, SGU_CHUNK, N_SGU_GROUPS, SGU_GROUP_DIM)
    mixed = jnp.einsum('gts,bnsgc->bntgc', w_s, v) + b_s.T[:, :, None]
    return u * mixed.reshape(B, S, SGU_WIDTH)


def hier_moe(h, w_rg, b_rg, w_re, b_re, w_gu, w_down):
    B, S, D = h.shape
    t = h.reshape(-1, D)
    T = t.shape[0]
    gp = jax.nn.softmax((t @ w_rg + b_rg).astype(jnp.float32), axis=-1)
    gval, gidx = lax.top_k(gp, 1)
    el = (t @ w_re + b_re).astype(jnp.float32).reshape(T, N_GROUPS, EXPERTS_PER_GROUP)
    el_sel = jnp.take_along_axis(el, gidx[:, :, None], axis=1)[:, 0]
    ep = jax.nn.softmax(el_sel, axis=-1)
    ev, eidx = lax.top_k(ep, TOP_K_IN_GROUP)
    ew = ev / jnp.sum(ev, axis=-1, keepdims=True) * gval
    gl_idx = gidx * EXPERTS_PER_GROUP + eidx
    combine = jnp.einsum('tk,tke->te', ew, jax.nn.one_hot(gl_idx, N_EXPERTS, dtype=jnp.float32))
    y = jnp.zeros((T, D), jnp.float32)
    for e in range(N_EXPERTS):
        gu = t @ w_gu[e]
        g, u = jnp.split(gu, 2, axis=-1)
        y = y + combine[:, e:e + 1] * ((jax.nn.silu(g) * u) @ w_down[e]).astype(jnp.float32)
    return y.astype(h.dtype).reshape(B, S, D)


def setup_inputs(seed: int = 0) -> dict:
    key = jax.random.key(seed)
    ks = jax.random.split(key, 32)
    f32 = jnp.float32
    L, D = DEPTH, D_MODEL
    nrm = lambda k, shape, s: jax.random.normal(k, shape, f32) * s
    return {
        "x": nrm(ks[0], (BATCH, SEQ, D), 1.0),
        "c": nrm(ks[1], (BATCH, D), 1.0),
        "w_ada": nrm(ks[2], (L, D, 6 * D), 0.5 * D ** -0.5),
        "b_ada": nrm(ks[3], (L, 6 * D), 0.02),
        "norm1_g": 1.0 + nrm(ks[4], (L, D), 0.02),
        "w_in": nrm(ks[5], (L, D, IN_WIDTH), D ** -0.5),
        "lambda_q1": nrm(ks[6], (L, DIFF_HEAD_DIM), 0.1),
        "lambda_k1": nrm(ks[7], (L, DIFF_HEAD_DIM), 0.1),
        "lambda_q2": nrm(ks[8], (L, DIFF_HEAD_DIM), 0.1),
        "lambda_k2": nrm(ks[9], (L, DIFF_HEAD_DIM), 0.1),
        "subln_g": 1.0 + nrm(ks[10], (L, 2 * DIFF_HEAD_DIM), 0.02),
        "w_attn_proj": nrm(ks[11], (L, ATTN_WIDTH, D), ATTN_WIDTH ** -0.5),
        "sgu_ln_g": 1.0 + nrm(ks[12], (L, SGU_WIDTH), 0.02),
        "sgu_ln_b": nrm(ks[13], (L, SGU_WIDTH), 0.02),
        "sgu_w_s": nrm(ks[14], (L, N_SGU_GROUPS, SGU_CHUNK, SGU_CHUNK), 0.5 * SGU_CHUNK ** -0.5),
        "sgu_b_s": 1.0 + nrm(ks[15], (L, N_SGU_GROUPS, SGU_CHUNK), 0.1),
        "w_sgu_proj": nrm(ks[16], (L, SGU_WIDTH, D), SGU_WIDTH ** -0.5),
        "w_out": nrm(ks[17], (L, D, D), D ** -0.5),
        "norm2_g": 1.0 + nrm(ks[18], (L, D), 0.02),
        "w_router_group": nrm(ks[19], (L, D, N_GROUPS), D ** -0.5),
        "b_router_group": nrm(ks[20], (L, N_GROUPS), 0.01),
        "w_router_expert": nrm(ks[21], (L, D, N_EXPERTS), D ** -0.5),
        "b_router_expert": nrm(ks[22], (L, N_EXPERTS), 0.01),
        "w_expert_gate_up": nrm(ks[23], (L, N_EXPERTS, D, 2 * D_EXPERT), D ** -0.5),
        "w_expert_down": nrm(ks[24], (L, N_EXPERTS, D_EXPERT, D), D_EXPERT ** -0.5),
        "final_g": 1.0 + nrm(ks[25], (D,), 0.02),
    }


def reference(x, c, w_ada, b_ada, norm1_g, w_in, lambda_q1, lambda_k1, lambda_q2, lambda_k2,
              subln_g, w_attn_proj, sgu_ln_g, sgu_ln_b, sgu_w_s, sgu_b_s, w_sgu_proj, w_out,
              norm2_g, w_router_group, b_router_group, w_router_expert, b_router_expert,
              w_expert_gate_up, w_expert_down, final_g):
    B, S = x.shape[0], x.shape[1]
    for l in range(DEPTH):
        mod = jax.nn.silu(c) @ w_ada[l] + b_ada[l]
        shift1, scale1, gate1, shift2, scale2, gate2 = jnp.split(mod, 6, axis=-1)

        h = modulate(rmsnorm(x, norm1_g[l]), shift1, scale1)
        q, k, v, u, s, ga, gb = jnp.split(h @ w_in[l], IN_SPLITS, axis=-1)
        q = q.reshape(B, S, N_DIFF_HEADS, 2, DIFF_HEAD_DIM)
        k = k.reshape(B, S, N_DIFF_HEADS, 2, DIFF_HEAD_DIM)
        v = v.reshape(B, S, N_DIFF_HEADS, 2 * DIFF_HEAD_DIM)
        lam_init = lambda_init_fn(l)
        lam = (jnp.exp(jnp.sum(lambda_q1[l] * lambda_k1[l]).astype(jnp.float32))
               - jnp.exp(jnp.sum(lambda_q2[l] * lambda_k2[l]).astype(jnp.float32)) + lam_init)
        y_attn = diff_attention(q, k, v, lam, subln_g[l], lam_init) @ w_attn_proj[l]
        y_sgu = spatial_gating(jax.nn.gelu(u), jax.nn.gelu(s), sgu_ln_g[l], sgu_ln_b[l],
                               sgu_w_s[l], sgu_b_s[l]) @ w_sgu_proj[l]
        y = jax.nn.sigmoid(ga) * y_attn + jax.nn.sigmoid(gb) * y_sgu
        x = x + gate1[:, None, :] * (y @ w_out[l])

        h2 = modulate(rmsnorm(x, norm2_g[l]), shift2, scale2)
        x = x + gate2[:, None, :] * hier_moe(h2, w_router_group[l], b_router_group[l],
                                             w_router_expert[l], b_router_expert[l],
                                             w_expert_gate_up[l], w_expert_down[l])
    return rmsnorm(x, final_g)
```

```cpp
#include <hip/hip_runtime.h>
#include <hip/hip_bf16.h>
#include <cstdio>
#include <cstdint>
namespace pg8 {
#define PG8_LAS __attribute__((address_space(3)))
typedef unsigned short bf16_t;
typedef short bf16x8 __attribute__((ext_vector_type(8)));
typedef float f32x4 __attribute__((ext_vector_type(4)));
typedef unsigned u32x4 __attribute__((ext_vector_type(4)));
constexpr int BM = 256, BK = 64, HALF = 128, HTB = HALF * BK * 2  , STAGE_BYTES = 8 * HTB, NXCD = 8, WGM = 8;

__host__ __device__ __forceinline__ int lds_byte(int r, int c) { const int st = (r >> 4) * 2 + (c >> 5), rr = r & 15, cc = c & 31, ob = rr * 64 + cc * 2; return st * 1024 + (ob ^ (((ob >> 9) & 1) << 5)); }
__host__ __device__ __forceinline__ void stage_rc(int b, int& R, int& C) { const int st = b / 1024, sb = b % 1024, swz = sb ^ (((sb >> 9) & 1) << 5); R = (st >> 1) * 16 + swz / 64; C = (st & 1) * 32 + (swz % 64) / 2; }
__host__ __device__ __forceinline__ int perm32(int rho) { const int n = rho >> 4, i = rho & 15; return 8 * (i >> 2) + 4 * n + (i & 3); }

struct Unit { int pm, pn; };
struct Gemm { const bf16_t* A; const bf16_t* Bt; int M, N, K; };

struct StaticOrder {
    int nM, nN, nwg, G, c;
    __host__ __device__ void init(int M, int N, int G_, int c_) { nM = M / BM; nN = N / BM; nwg = nM * nN; G = G_; c = c_; }
    __host__ __device__ bool next(int i, Unit& u) const {
        const long L = (long)i * G + c; if (L >= nwg) return false;
        int wgid = (int)L; { const int q = nwg / NXCD, r = nwg % NXCD, xcd = wgid % NXCD, off = wgid / NXCD; wgid = (xcd < r ? xcd * (q + 1) : r * (q + 1) + (xcd - r) * q) + off; }
        const int nig = WGM * nN, gid = wgid / nig, fm = gid * WGM, gsz = (nM - fm) < WGM ? (nM - fm) : WGM;
        u.pm = fm + ((wgid % nig) % gsz); u.pn = (wgid % nig) / gsz; return true;
    }
    __device__ __forceinline__ void a_ready(const Unit&) const {}
    __device__ __forceinline__ void done(const Unit&) const {}
};

__device__ __forceinline__ unsigned cvt_pk_bf16(float lo, float hi) { unsigned r; asm volatile("v_cvt_pk_bf16_f32 %0, %1, %2" : "=v"(r) : "v"(lo), "v"(hi)); return r; }
typedef float f32x2 __attribute__((ext_vector_type(2)));

template <class Epi, class Sched, bool ALIGN_EPI = false, bool SP2 = false>
__device__ __forceinline__ void gemm_phase(PG8_LAS unsigned char* lds, const Gemm g, const Sched& S, const Epi& E) {
    const int tid = threadIdx.x, wid = __builtin_amdgcn_readfirstlane(tid >> 6), lane = tid & 63, wr = wid >> 2, wc = wid & 3, fr = lane & 15, fq = lane >> 4;
    const int K = g.K, nt = K / BK;
    unsigned voffA[2], voffB[2];
#pragma unroll
    for (int i = 0; i < 2; ++i) { int R, C; stage_rc(tid * 16 + i * 8192, R, C); const int Rb = Epi::PERM ? ((R & ~31) + perm32(R & 31)) : R;
        voffA[i] = (unsigned)(R * K + C) * 2u; voffB[i] = (unsigned)(Rb * K + C) * 2u; }
    const size_t kstep = (size_t)(BK * 2);
    const size_t hstep = (size_t)HALF * K * 2;
    const size_t tstep = 2 * hstep;
    const unsigned ldsw = (unsigned)wid * 1024u;
    const int aoff = lds_byte(wr * 64 + fr, fq * 8), boff = lds_byte(wc * 32 + fr, fq * 8);
#define PG8_SA(b, h) (((b) * 2 + (h)) * HTB)
#define PG8_SB(b, h) ((4 + (b) * 2 + (h)) * HTB)
#define PG8_STAGE(bufoff, gbase, voff) do { _Pragma("unroll") for (int _i = 0; _i < 2; ++_i) \
        __builtin_amdgcn_global_load_lds((const unsigned*)((const char*)(gbase) + (voff)[_i]), (PG8_LAS unsigned*)(lds + (bufoff) + ldsw + _i * 8192), 16, 0, 0); } while (0)
#define PG8_LDA(dst, b, h) do { _Pragma("unroll") for (int m = 0; m < 4; ++m) _Pragma("unroll") for (int k = 0; k < 2; ++k) dst[m][k] = *(const PG8_LAS bf16x8*)(lds + PG8_SA(b, h) + aoff + m * 2048 + k * 1024); } while (0)
#define PG8_LDB(dst, b, h) do { _Pragma("unroll") for (int n = 0; n < 2; ++n) _Pragma("unroll") for (int k = 0; k < 2; ++k) dst[n][k] = *(const PG8_LAS bf16x8*)(lds + PG8_SB(b, h) + boff + n * 2048 + k * 1024); } while (0)
#define PG8_MMA(ai, bj, At, Bt) do { __builtin_amdgcn_s_setprio(1); _Pragma("unroll") for (int m = 0; m < 4; ++m) _Pragma("unroll") for (int n = 0; n < 2; ++n) _Pragma("unroll") for (int k = 0; k < 2; ++k) \
        acc[ai][bj][m][n] = __builtin_amdgcn_mfma_f32_16x16x32_bf16(Bt[n][k], At[m][k], acc[ai][bj][m][n], 0, 0, 0); __builtin_amdgcn_s_setprio(0); } while (0)
#define PG8_WAIT_V(n) asm volatile("s_waitcnt vmcnt(" #n ")" ::: "memory")
#define PG8_WAIT_L(n) asm volatile("s_waitcnt lgkmcnt(" #n ")" ::: "memory")
#define PG8_BAR __builtin_amdgcn_s_barrier()
#define PG8_SCHED __builtin_amdgcn_sched_barrier(0)
    Unit cur, nxt; int ui = 0;
    if (!S.next(0, cur)) return;
    f32x4 acc[2][2][4][2];
#pragma unroll
    for (int a = 0; a < 2; ++a)
#pragma unroll
        for (int b = 0; b < 2; ++b)
#pragma unroll
            for (int m = 0; m < 4; ++m)
#pragma unroll
                for (int n = 0; n < 2; ++n) acc[a][b][m][n] = (f32x4){0.f, 0.f, 0.f, 0.f};
    bf16x8 At[4][2], B0[2][2], B1[2][2];
    const char* cA = (const char*)g.A + (size_t)cur.pm * tstep; const char* cB = (const char*)g.Bt + (size_t)cur.pn * tstep;
    S.a_ready(cur);
    if constexpr (SP2) {
        PG8_STAGE(PG8_SB(0, 0), cB, voffB); PG8_STAGE(PG8_SB(0, 1), cB + hstep, voffB); PG8_STAGE(PG8_SA(0, 0), cA, voffA); PG8_STAGE(PG8_SA(0, 1), cA + hstep, voffA);
        if (wr == 1) PG8_BAR;
        PG8_WAIT_V(2); PG8_BAR;
        PG8_STAGE(PG8_SB(1, 0), cB + kstep, voffB); PG8_STAGE(PG8_SA(1, 0), cA + kstep, voffA); PG8_STAGE(PG8_SB(1, 1), cB + hstep + kstep, voffB);
        PG8_WAIT_V(6); PG8_BAR;
    } else {
        PG8_STAGE(PG8_SB(0, 0), cB, voffB); PG8_STAGE(PG8_SA(0, 0), cA, voffA); PG8_STAGE(PG8_SB(0, 1), cB + hstep, voffB); PG8_STAGE(PG8_SA(0, 1), cA + hstep, voffA);
        if (wr == 1) PG8_BAR;
        PG8_WAIT_V(4); PG8_BAR;
        PG8_STAGE(PG8_SB(1, 0), cB + kstep, voffB); PG8_STAGE(PG8_SA(1, 0), cA + kstep, voffA); PG8_STAGE(PG8_SB(1, 1), cB + hstep + kstep, voffB);
        PG8_WAIT_V(6); PG8_BAR;
    }
    for (;;) {
        const bool has_next = S.next(ui + 1, nxt);
        const char* nA = has_next ? (const char*)g.A + (size_t)nxt.pm * tstep : cA; const char* nB = has_next ? (const char*)g.Bt + (size_t)nxt.pn * tstep : cB;
        for (int t = 0; t < nt; t += 2) {
            const bool last = (t == nt - 2);
            const char* a1 = cA + (size_t)(t + 1) * kstep;
            const char* a2 = last ? nA : cA + (size_t)(t + 2) * kstep; const char* b2 = last ? nB : cB + (size_t)(t + 2) * kstep;
            const char* a3 = a2 + kstep; const char* b3 = b2 + kstep;
            if (last && has_next) S.a_ready(nxt);
            if constexpr (SP2) {
            PG8_LDB(B0, 0, 0); PG8_LDB(B1, 0, 1); PG8_SCHED; PG8_LDA(At, 0, 0); PG8_STAGE(PG8_SA(1, 1), a1 + hstep, voffA);
            PG8_WAIT_V(8); PG8_WAIT_L(0); PG8_BAR; PG8_MMA(0, 0, At, B0); PG8_MMA(0, 1, At, B1); PG8_BAR; PG8_SCHED;
            PG8_LDA(At, 0, 1); PG8_STAGE(PG8_SB(0, 0), b2, voffB); PG8_STAGE(PG8_SB(0, 1), b2 + hstep, voffB); PG8_STAGE(PG8_SA(0, 0), a2, voffA);
            PG8_WAIT_V(8); PG8_WAIT_L(0); PG8_BAR; PG8_MMA(1, 0, At, B0); PG8_MMA(1, 1, At, B1); PG8_BAR; PG8_SCHED;
            PG8_LDB(B0, 1, 0); PG8_LDB(B1, 1, 1); PG8_SCHED; PG8_LDA(At, 1, 0); PG8_STAGE(PG8_SA(0, 1), a2 + hstep, voffA);
            PG8_WAIT_V(8); PG8_WAIT_L(0); PG8_BAR; PG8_MMA(0, 0, At, B0); PG8_MMA(0, 1, At, B1); PG8_BAR; PG8_SCHED;
            PG8_LDA(At, 1, 1); PG8_STAGE(PG8_SB(1, 0), b3, voffB); PG8_STAGE(PG8_SB(1, 1), b3 + hstep, voffB); PG8_STAGE(PG8_SA(1, 0), a3, voffA);
            PG8_WAIT_V(8); PG8_WAIT_L(0); PG8_BAR; PG8_MMA(1, 0, At, B0); PG8_MMA(1, 1, At, B1); PG8_BAR; PG8_SCHED;
            } else {
            PG8_LDB(B0, 0, 0); PG8_SCHED; PG8_LDA(At, 0, 0); PG8_STAGE(PG8_SA(1, 1), a1 + hstep, voffA);
            PG8_WAIT_L(8); PG8_BAR; PG8_WAIT_L(0); PG8_MMA(0, 0, At, B0); PG8_BAR; PG8_SCHED;
            PG8_LDB(B1, 0, 1); PG8_STAGE(PG8_SB(0, 0), b2, voffB);
            PG8_BAR; PG8_WAIT_L(0); PG8_MMA(0, 1, At, B1); PG8_BAR;
            PG8_LDA(At, 0, 1); PG8_STAGE(PG8_SA(0, 0), a2, voffA);
            PG8_BAR; PG8_WAIT_L(0); PG8_MMA(1, 0, At, B0); PG8_BAR; PG8_SCHED;
            PG8_STAGE(PG8_SB(0, 1), b2 + hstep, voffB);
            PG8_WAIT_V(6); PG8_BAR; PG8_MMA(1, 1, At, B1); PG8_BAR;
            PG8_LDB(B0, 1, 0); PG8_SCHED; PG8_LDA(At, 1, 0); PG8_STAGE(PG8_SA(0, 1), a2 + hstep, voffA);
            PG8_WAIT_L(8); PG8_BAR; PG8_WAIT_L(0); PG8_MMA(0, 0, At, B0); PG8_BAR; PG8_SCHED;
            PG8_LDB(B1, 1, 1); PG8_STAGE(PG8_SB(1, 0), b3, voffB);
            PG8_BAR; PG8_WAIT_L(0); PG8_MMA(0, 1, At, B1); PG8_BAR;
            PG8_LDA(At, 1, 1); PG8_STAGE(PG8_SA(1, 0), a3, voffA);
            PG8_BAR; PG8_WAIT_L(0); PG8_MMA(1, 0, At, B0); PG8_BAR; PG8_SCHED;
            PG8_STAGE(PG8_SB(1, 1), b3 + hstep, voffB);
            PG8_WAIT_V(6); PG8_BAR; PG8_MMA(1, 1, At, B1); PG8_BAR;
            }
        }
        if constexpr (ALIGN_EPI) { if (wr == 0) PG8_BAR; }
        if constexpr (!Epi::AFTER_DRAIN) { E(acc, cur, wr, wc, fr, fq); S.done(cur); }
        if (!has_next) break;
#pragma unroll
        for (int a = 0; a < 2; ++a)
#pragma unroll
            for (int b = 0; b < 2; ++b)
#pragma unroll
                for (int m = 0; m < 4; ++m)
#pragma unroll
                    for (int n = 0; n < 2; ++n) acc[a][b][m][n] = (f32x4){0.f, 0.f, 0.f, 0.f};
        cur = nxt; cA = nA; cB = nB; ++ui;
        if constexpr (ALIGN_EPI) { if (wr == 1) PG8_BAR; }
    }
    PG8_WAIT_V(0);
    if constexpr (!ALIGN_EPI) { if (wr == 0) PG8_BAR; }
    PG8_BAR;
    if constexpr (Epi::AFTER_DRAIN) { E.fused(acc, cur, wr, wc, fr, fq, lds, wid, lane); S.done(cur); }
#undef PG8_SA
#undef PG8_SB
#undef PG8_STAGE
#undef PG8_LDA
#undef PG8_LDB
#undef PG8_MMA
#undef PG8_WAIT_V
#undef PG8_WAIT_L
#undef PG8_BAR
#undef PG8_SCHED
}

__device__ __forceinline__ float bf_lo(unsigned w) { return __builtin_bit_cast(float, w << 16); }
__device__ __forceinline__ float bf_hi(unsigned w) { return __builtin_bit_cast(float, w & 0xffff0000u); }
__device__ __forceinline__ float sigmoid_f(float x) { return __builtin_amdgcn_rcpf(1.0f + __builtin_amdgcn_exp2f(-1.4426950408889634f * x)); }
__device__ __forceinline__ float gelu_tanh_f(float x) { const float u = x * (1.0f + 0.044715f * x * x); return x * __builtin_amdgcn_rcpf(1.0f + __builtin_amdgcn_exp2f(-2.3022081981f * u)); }
__device__ __forceinline__ u32x4 pack8(f32x4 a, f32x4 b) { u32x4 w; w.x = cvt_pk_bf16(a[0], a[1]); w.y = cvt_pk_bf16(a[2], a[3]); w.z = cvt_pk_bf16(b[0], b[1]); w.w = cvt_pk_bf16(b[2], b[3]); return w; }

struct EpiIn {
    static constexpr bool PERM = true, AFTER_DRAIN = false;
    bf16_t* reg5; bf16_t* reg2; size_t rstride; float qscale;
    __device__ __forceinline__ void operator()(const f32x4 (&acc)[2][2][4][2], const Unit& u, int wr, int wc, int fr, int fq) const {
        const int region = u.pn >> 2, colt = (u.pn & 3) * BM;
        bf16_t* base = (region < 5) ? reg5 + (size_t)region * rstride : reg2 + (size_t)(region - 5) * rstride;
        const int row0 = u.pm * BM + wr * 64 + fr, col0 = colt + wc * 32 + 8 * fq;
        const int mode = (region < 3) ? 0 : (region < 5 ? 1 : 2);
        const float sc = (region == 0) ? qscale : 1.0f;
#pragma unroll
        for (int ai = 0; ai < 2; ++ai)
#pragma unroll
            for (int m = 0; m < 4; ++m) { bf16_t* rowp = base + (size_t)(row0 + ai * HALF + m * 16) * 1024 + col0;
#pragma unroll
                for (int bj = 0; bj < 2; ++bj) { f32x4 v0 = acc[ai][bj][m][0], v1 = acc[ai][bj][m][1];
                    if (mode == 0) { v0 = v0 * sc; v1 = v1 * sc; }
                    else if (mode == 1) {
#pragma unroll
                        for (int e = 0; e < 4; ++e) { v0[e] = gelu_tanh_f(v0[e]); v1[e] = gelu_tanh_f(v1[e]); } }
                    else {
#pragma unroll
                        for (int e = 0; e < 4; ++e) { v0[e] = sigmoid_f(v0[e]); v1[e] = sigmoid_f(v1[e]); } }
                    *(u32x4*)(rowp + bj * HALF) = pack8(v0, v1); } }
    }
};

template <bool FIRST> struct EpiGate {
    static constexpr bool PERM = true, AFTER_DRAIN = false;
    const bf16_t* G; bf16_t* Y;
    __device__ __forceinline__ void operator()(const f32x4 (&acc)[2][2][4][2], const Unit& u, int wr, int wc, int fr, int fq) const {
        const int row0 = u.pm * BM + wr * 64 + fr, col0 = u.pn * BM + wc * 32 + 8 * fq;
#pragma unroll
        for (int ai = 0; ai < 2; ++ai)
#pragma unroll
            for (int m = 0; m < 4; ++m) { const size_t ro = (size_t)(row0 + ai * HALF + m * 16) * 1024 + col0;
#pragma unroll
                for (int bj = 0; bj < 2; ++bj) { const u32x4 g = *(const u32x4*)(G + ro + bj * HALF);
                    f32x4 v0 = acc[ai][bj][m][0], v1 = acc[ai][bj][m][1];
                    v0[0] *= bf_lo(g.x); v0[1] *= bf_hi(g.x); v0[2] *= bf_lo(g.y); v0[3] *= bf_hi(g.y);
                    v1[0] *= bf_lo(g.z); v1[1] *= bf_hi(g.z); v1[2] *= bf_lo(g.w); v1[3] *= bf_hi(g.w);
                    if (!FIRST) { const u32x4 y = *(const u32x4*)(Y + ro + bj * HALF);
                        v0[0] += bf_lo(y.x); v0[1] += bf_hi(y.x); v0[2] += bf_lo(y.y); v0[3] += bf_hi(y.y);
                        v1[0] += bf_lo(y.z); v1[1] += bf_hi(y.z); v1[2] += bf_lo(y.w); v1[3] += bf_hi(y.w); }
                    *(u32x4*)(Y + ro + bj * HALF) = pack8(v0, v1); } }
    }
};

struct EpiRes {
    static constexpr bool PERM = true, AFTER_DRAIN = false;
    const float* X; float* O; const float* gate; int modld; int rpb;
    __device__ __forceinline__ void operator()(const f32x4 (&acc)[2][2][4][2], const Unit& u, int wr, int wc, int fr, int fq) const {
        const int row0 = u.pm * BM + wr * 64 + fr, col0 = u.pn * BM + wc * 32 + 8 * fq;
        const float* gp = gate + (size_t)((u.pm * BM) / rpb) * modld + col0;
        f32x4 gv[2][2];
#pragma unroll
        for (int bj = 0; bj < 2; ++bj)
#pragma unroll
            for (int n = 0; n < 2; ++n) gv[bj][n] = *(const f32x4*)(gp + bj * HALF + 4 * n);
#pragma unroll
        for (int ai = 0; ai < 2; ++ai)
#pragma unroll
            for (int m = 0; m < 4; ++m) { const size_t ro = (size_t)(row0 + ai * HALF + m * 16) * 1024 + col0;
#pragma unroll
                for (int bj = 0; bj < 2; ++bj)
#pragma unroll
                    for (int n = 0; n < 2; ++n) { const f32x4 xv = *(const f32x4*)(X + ro + bj * HALF + 4 * n);
                        *(f32x4*)(O + ro + bj * HALF + 4 * n) = xv + gv[bj][n] * acc[ai][bj][m][n]; } }
    }
};

struct EpiGU {
    static constexpr bool PERM = true, AFTER_DRAIN = false;
    bf16_t* ACT;
    __device__ __forceinline__ void operator()(const f32x4 (&acc)[2][2][4][2], const Unit& u, int wr, int wc, int fr, int fq) const {
        const int row0 = u.pm * BM + wr * 64 + fr, col0 = (u.pn & 1) * HALF + wc * 32 + 8 * fq;
#pragma unroll
        for (int ai = 0; ai < 2; ++ai)
#pragma unroll
            for (int m = 0; m < 4; ++m) { f32x4 v[2];
#pragma unroll
                for (int n = 0; n < 2; ++n)
#pragma unroll
                    for (int e = 0; e < 4; ++e) { const float g = acc[ai][0][m][n][e]; v[n][e] = g * sigmoid_f(g) * acc[ai][1][m][n][e]; }
                *(u32x4*)(ACT + (size_t)(row0 + ai * HALF + m * 16) * 256 + col0) = pack8(v[0], v[1]); }
    }
};

struct EpiDown {
    static constexpr bool PERM = true, AFTER_DRAIN = false;
    bf16_t* EO;
    __device__ __forceinline__ void operator()(const f32x4 (&acc)[2][2][4][2], const Unit& u, int wr, int wc, int fr, int fq) const {
        const int row0 = u.pm * BM + wr * 64 + fr, col0 = (u.pn & 3) * BM + wc * 32 + 8 * fq;
#pragma unroll
        for (int ai = 0; ai < 2; ++ai)
#pragma unroll
            for (int m = 0; m < 4; ++m) { bf16_t* rowp = EO + (size_t)(row0 + ai * HALF + m * 16) * 1024 + col0;
#pragma unroll
                for (int bj = 0; bj < 2; ++bj) *(u32x4*)(rowp + bj * HALF) = pack8(acc[ai][bj][m][0], acc[ai][bj][m][1]); }
    }
};

template <int NPN> struct MoeOrder {
    const volatile PG8_LAS int* tbl; int ntiles, G, c;
    __device__ __forceinline__ bool next(int i, Unit& u) const {
        const int L = i * G + c; if (L >= ntiles * NPN) return false;
        u.pm = L / NPN; u.pn = __builtin_amdgcn_readfirstlane(tbl[u.pm]) * NPN + (L % NPN); return true;
    }
    __device__ __forceinline__ void a_ready(const Unit&) const {}
    __device__ __forceinline__ void done(const Unit&) const {}
};
}

namespace att {
typedef unsigned short bf16;
using bf16x8 = __attribute__((ext_vector_type(8))) short;
using s16x4 = __attribute__((ext_vector_type(4))) short;
using f32x16 = __attribute__((ext_vector_type(16))) float;
using u32x4 = __attribute__((ext_vector_type(4))) unsigned;
typedef float f32x4 __attribute__((ext_vector_type(4)));
typedef short v4i16_t __attribute__((ext_vector_type(4)));
typedef __attribute__((address_space(3))) const char* lds_cptr;
constexpr int SEQ = 2048, DM = 1024, KVB = 64, NT = SEQ / KVB, QROWS = 128;
constexpr int SLOT = 16384, L_K = 0, L_V = 3 * SLOT, L_WS = 6 * SLOT, L_X = 0, ATT_LDS = L_WS + 8 * 64 * 4;
constexpr float THR = 8.0f;
__device__ __forceinline__ int crow(int r, int hi) { return (r & 3) + 8 * (r >> 2) + 4 * hi; }
__device__ __forceinline__ void glds16(const void* gsrc, unsigned lds_dst) { unsigned keep;
    asm volatile("s_mov_b32 %0, m0\n\ts_mov_b32 m0, %2\n\ts_nop 0\n\tglobal_load_lds_dwordx4 %1, off\n\ts_mov_b32 m0, %0" : "=&s"(keep) : "v"(gsrc), "s"(lds_dst) : "memory"); }
typedef float f32x2_t __attribute__((ext_vector_type(2))); typedef __bf16 bf16x2_t __attribute__((ext_vector_type(2)));
__device__ __forceinline__ unsigned cvtpk(float lo, float hi) { f32x2_t v = {lo, hi}; bf16x2_t b = __builtin_convertvector(v, bf16x2_t); return __builtin_bit_cast(unsigned, b); }
__device__ __forceinline__ s16x4 vtr(lds_cptr p) { return __builtin_bit_cast(s16x4, __builtin_amdgcn_ds_read_tr16_b64_v4i16((__attribute__((address_space(3))) v4i16_t*)p)); }
#define ATT_WAIT_BAR(N) asm volatile("s_waitcnt vmcnt(" #N ") lgkmcnt(0)\n\ts_barrier" ::: "memory")

__device__ __forceinline__ void attn_unit(int b, int h, int qb, const bf16* Q, const bf16* __restrict__ K, const bf16* __restrict__ V, bf16* O, char* shm, float lam, float slope2, const float* __restrict__ subg, float oscale) {
    const int tid = threadIdx.x, lane = tid & 63, r32 = lane & 31, hi = lane >> 5;
    const int wid = __builtin_amdgcn_readfirstlane(tid >> 6), mp = wid >> 2, wq = wid & 3;
    const long rowbase = (long)b * SEQ; const int q0 = qb * QROWS;
    const bf16* Qw = Q + (rowbase + q0 + wq * 32) * DM + h * 128 + mp * 64;
    const bf16* Kh = K + rowbase * DM + h * 128; const bf16* Vh = V + rowbase * DM + h * 128;
    const unsigned lds0 = (unsigned)(uintptr_t)shm;
    volatile __attribute__((address_space(3))) float* wsf = (volatile __attribute__((address_space(3))) float*)((__attribute__((address_space(3))) char*)shm + L_WS) + wid * 64;
    const bf16* ksrc = Kh + (long)lane * DM + (2 * wid) * 8;
    const bf16* vsrc = Vh + (long)(16 * (2 * (wid & 1)) + (lane >> 2)) * DM + (wid >> 1) * 32 + (lane & 3) * 8;
    const unsigned kdst = lds0 + L_K + (2 * wid) * 1024, vdst = lds0 + L_V + (2 * wid) * 1024;
#define ATT_DMA(t, so) do { const long go_ = (long)(t) * KVB * DM; const unsigned so_ = (unsigned)(so); \
        glds16(ksrc + go_, (unsigned)__builtin_amdgcn_readfirstlane(kdst + so_)); glds16(ksrc + go_ + 8, (unsigned)__builtin_amdgcn_readfirstlane(kdst + so_ + 1024)); \
        glds16(vsrc + go_, (unsigned)__builtin_amdgcn_readfirstlane(vdst + so_)); glds16(vsrc + go_ + 16 * DM, (unsigned)__builtin_amdgcn_readfirstlane(vdst + so_ + 1024)); } while (0)
    ATT_DMA(0, 0); ATT_DMA(1, SLOT);
    bf16x8 qr[4];
#pragma unroll
    for (int d0 = 0; d0 < 4; ++d0) qr[d0] = *reinterpret_cast<const bf16x8*>(&Qw[(long)r32 * DM + d0 * 16 + hi * 8]);
    asm volatile("" : "+v"(qr[0]), "+v"(qr[1]), "+v"(qr[2]), "+v"(qr[3]));
    const lds_cptr shm3 = (lds_cptr)shm;
    const lds_cptr kp0 = shm3 + L_K + (8 * mp + hi) * 1024 + r32 * 16;
    const lds_cptr vp0 = shm3 + L_V + ((lane >> 4) & 1) * 32 + (lane & 3) * 8 + (4 * hi + ((lane & 15) >> 2)) * 64;
    const int qpos = q0 + wq * 32 + r32;
    float mhat = -1e30f, lsum = 0.f;
    f32x16 o[4];
#pragma unroll
    for (int i = 0; i < 4; ++i) o[i] = f32x16{};
    int slot = 0;
    for (int t = 0; t < NT; ++t) {
        if (t + 1 < NT) { ATT_WAIT_BAR(4); } else { ATT_WAIT_BAR(0); }
        if (t + 2 < NT) { const int s2 = (slot >= SLOT) ? slot - SLOT : slot + 2 * SLOT; ATT_DMA(t + 2, s2); }
        f32x16 p0 = f32x16{}, p1 = f32x16{};
        const lds_cptr kp = kp0 + slot;
#pragma unroll
        for (int d0 = 0; d0 < 4; ++d0) {
            const bf16x8 a0 = *(const __attribute__((address_space(3))) bf16x8*)(kp + d0 * 2048);
            const bf16x8 a1 = *(const __attribute__((address_space(3))) bf16x8*)(kp + d0 * 2048 + 512);
            p0 = __builtin_amdgcn_mfma_f32_32x32x16_bf16(a0, qr[d0], p0, 0, 0, 0);
            p1 = __builtin_amdgcn_mfma_f32_32x32x16_bf16(a1, qr[d0], p1, 0, 0, 0);
        }
        const float dq = (float)(t * KVB + 4 * hi - qpos);
#pragma unroll
        for (int r = 0; r < 16; ++r) { const float c = (float)((r & 3) + 8 * (r >> 2));
            p0[r] = __builtin_fmaf(-slope2, __builtin_fabsf(dq + c), p0[r]);
            p1[r] = __builtin_fmaf(-slope2, __builtin_fabsf(dq + (c + 32.f)), p1[r]); }
        float rm = __builtin_fmaxf(p0[0], p1[0]);
#pragma unroll
        for (int r = 1; r < 16; ++r) rm = __builtin_fmaxf(rm, __builtin_fmaxf(p0[r], p1[r]));
        { auto rr = __builtin_amdgcn_permlane32_swap(__float_as_uint(rm), __float_as_uint(rm), false, false); rm = __builtin_fmaxf(__uint_as_float(rr[0]), __uint_as_float(rr[1])); }
        bool resc = false;
        if (__any(rm > mhat + THR)) {
            const float mn = __builtin_fmaxf(mhat, rm); const float f = __builtin_amdgcn_exp2f(mhat - mn); mhat = mn; lsum *= f;
            if (hi == 0) wsf[r32] = f; resc = true; }
        float sacc = 0.f;
#pragma unroll
        for (int r = 0; r < 16; ++r) { p0[r] = __builtin_amdgcn_exp2f(p0[r] - mhat); p1[r] = __builtin_amdgcn_exp2f(p1[r] - mhat); sacc += p0[r] + p1[r]; }
        lsum += sacc;
        u32x4 pw0, pw1, pw2, pw3;
        pw0 = (u32x4){cvtpk(p0[0], p0[1]), cvtpk(p0[2], p0[3]), cvtpk(p0[4], p0[5]), cvtpk(p0[6], p0[7])};
        pw1 = (u32x4){cvtpk(p0[8], p0[9]), cvtpk(p0[10], p0[11]), cvtpk(p0[12], p0[13]), cvtpk(p0[14], p0[15])};
        pw2 = (u32x4){cvtpk(p1[0], p1[1]), cvtpk(p1[2], p1[3]), cvtpk(p1[4], p1[5]), cvtpk(p1[6], p1[7])};
        pw3 = (u32x4){cvtpk(p1[8], p1[9]), cvtpk(p1[10], p1[11]), cvtpk(p1[12], p1[13]), cvtpk(p1[14], p1[15])};
        if (resc) {
            asm volatile("s_waitcnt lgkmcnt(0)" ::: "memory");
#pragma unroll
            for (int r = 0; r < 16; ++r) { const float f = wsf[crow(r, hi)];
#pragma unroll
                for (int db = 0; db < 4; ++db) o[db][r] *= f; }
        }
        const lds_cptr vp = vp0 + slot;
#pragma unroll
        for (int db = 0; db < 4; ++db) {
#pragma unroll
            for (int ks = 0; ks < 4; ++ks) {
                const s16x4 lo = vtr(vp + db * 4096 + ks * 1024), hh = vtr(vp + db * 4096 + ks * 1024 + 512);
                const bf16x8 vf = (bf16x8){lo[0], lo[1], lo[2], lo[3], hh[0], hh[1], hh[2], hh[3]};
                const u32x4 pw = (ks == 0) ? pw0 : (ks == 1) ? pw1 : (ks == 2) ? pw2 : pw3;
                o[db] = __builtin_amdgcn_mfma_f32_32x32x16_bf16(__builtin_bit_cast(bf16x8, pw), vf, o[db], 0, 0, 0);
            }
        }
        slot = (slot == 2 * SLOT) ? 0 : slot + SLOT;
    }
#undef ATT_DMA
    { auto rr = __builtin_amdgcn_permlane32_swap(__float_as_uint(lsum), __float_as_uint(lsum), false, false); lsum = __uint_as_float(rr[0]) + __uint_as_float(rr[1]); }
    if (hi == 0) wsf[32 + r32] = lsum;
    asm volatile("s_waitcnt lgkmcnt(0)" ::: "memory");
    float rli[16];
#pragma unroll
    for (int r = 0; r < 16; ++r) rli[r] = __builtin_amdgcn_rcpf(wsf[32 + crow(r, hi)]);
    ATT_WAIT_BAR(0);
    __attribute__((address_space(3))) float* xch = (__attribute__((address_space(3))) float*)((__attribute__((address_space(3))) char*)shm + L_X) + wq * 4096 + lane;
    if (mp == 1) {
#pragma unroll
        for (int db = 0; db < 4; ++db)
#pragma unroll
            for (int r = 0; r < 16; ++r) xch[(db * 16 + r) * 64] = o[db][r] * (rli[r] * lam);
    }
    ATT_WAIT_BAR(0);
    if (mp == 0) {
        float ss[16];
#pragma unroll
        for (int r = 0; r < 16; ++r) ss[r] = 0.f;
#pragma unroll
        for (int db = 0; db < 4; ++db)
#pragma unroll
            for (int r = 0; r < 16; ++r) { const float v = o[db][r] * rli[r] - xch[(db * 16 + r) * 64]; o[db][r] = v; ss[r] += v * v; }
#pragma unroll
        for (int r = 0; r < 16; ++r) {
#pragma unroll
            for (int off = 1; off < 32; off <<= 1) ss[r] += __shfl_xor(ss[r], off);
            ss[r] = oscale * __builtin_amdgcn_rsqf(ss[r] * (1.0f / 128.0f) + 1e-6f); }
        bf16* Ow = O + (rowbase + q0 + wq * 32) * DM + h * 128 + r32;
#pragma unroll
        for (int db = 0; db < 4; ++db) { const float g = subg[db * 32 + r32];
#pragma unroll
            for (int r = 0; r < 16; ++r) { const float v = o[db][r] * ss[r] * g; Ow[(long)crow(r, hi) * DM + db * 32] = (bf16)(cvtpk(v, v) & 0xffffu); } }
    }
    ATT_WAIT_BAR(0);
}

constexpr int SG_B = 0, SG_STAT = 32768, SG_LDS = SG_STAT + 128 * 8;
__device__ __forceinline__ void sgu_unit(int b, int n, const bf16* GS, bf16* GU, const bf16* __restrict__ Wsb, const float* __restrict__ bs, const float* __restrict__ lng, const float* __restrict__ lnb, char* shm) {
    const int tid = threadIdx.x, lane = tid & 63, r32 = lane & 31, hi = lane >> 5;
    const int wid = __builtin_amdgcn_readfirstlane(tid >> 6);
    const long row0 = (long)b * SEQ + n * 128;
    __attribute__((address_space(3))) float* stat = (__attribute__((address_space(3))) float*)((__attribute__((address_space(3))) char*)shm + SG_STAT);
    for (int i = 0; i < 16; ++i) { const int row = wid * 16 + i; const bf16* rp = GS + (row0 + row) * DM;
        const u32x4 a = *(const u32x4*)(rp + lane * 8), c = *(const u32x4*)(rp + 512 + lane * 8);
        float v[16];
        v[0] = pg8::bf_lo(a.x); v[1] = pg8::bf_hi(a.x); v[2] = pg8::bf_lo(a.y); v[3] = pg8::bf_hi(a.y); v[4] = pg8::bf_lo(a.z); v[5] = pg8::bf_hi(a.z); v[6] = pg8::bf_lo(a.w); v[7] = pg8::bf_hi(a.w);
        v[8] = pg8::bf_lo(c.x); v[9] = pg8::bf_hi(c.x); v[10] = pg8::bf_lo(c.y); v[11] = pg8::bf_hi(c.y); v[12] = pg8::bf_lo(c.z); v[13] = pg8::bf_hi(c.z); v[14] = pg8::bf_lo(c.w); v[15] = pg8::bf_hi(c.w);
        float s = 0.f;
#pragma unroll
        for (int k = 0; k < 16; ++k) s += v[k];
#pragma unroll
        for (int off = 1; off < 64; off <<= 1) s += __shfl_xor(s, off);
        const float mean = s * (1.0f / 1024.0f); float s2 = 0.f;
#pragma unroll
        for (int k = 0; k < 16; ++k) { const float d = v[k] - mean; s2 += d * d; }
#pragma unroll
        for (int off = 1; off < 64; off <<= 1) s2 += __shfl_xor(s2, off);
        if (lane == 0) { stat[2 * row] = mean; stat[2 * row + 1] = __builtin_amdgcn_rsqf(s2 * (1.0f / 1024.0f) + 1e-6f); }
    }
    __syncthreads();
    const int tb = wid >> 1, ch = wid & 1;
    for (int g = 0; g < 8; ++g) {
#pragma unroll
        for (int i = 0; i < 4; ++i) { const int idx = tid + 512 * i, s = idx >> 4, c0 = (idx & 15) * 8;
            const u32x4 a = *(const u32x4*)(GS + (row0 + s) * DM + g * 128 + c0);
            const float mean = stat[2 * s], rstd = stat[2 * s + 1];
            const f32x4 g0 = *(const f32x4*)(lng + g * 128 + c0), g1 = *(const f32x4*)(lng + g * 128 + c0 + 4), b0 = *(const f32x4*)(lnb + g * 128 + c0), b1 = *(const f32x4*)(lnb + g * 128 + c0 + 4);
            f32x4 x0 = {pg8::bf_lo(a.x), pg8::bf_hi(a.x), pg8::bf_lo(a.y), pg8::bf_hi(a.y)}, x1 = {pg8::bf_lo(a.z), pg8::bf_hi(a.z), pg8::bf_lo(a.w), pg8::bf_hi(a.w)};
            x0 = (x0 - mean) * rstd * g0 + b0; x1 = (x1 - mean) * rstd * g1 + b1;
            u32x4 w; w.x = cvtpk(x0[0], x0[1]); w.y = cvtpk(x0[2], x0[3]); w.z = cvtpk(x1[0], x1[1]); w.w = cvtpk(x1[2], x1[3]);
            *(__attribute__((address_space(3))) u32x4*)((__attribute__((address_space(3))) char*)shm + SG_B + (c0 >> 5) * 8192 + s * 64 + (c0 & 31) * 2) = w; }
        __syncthreads();
        f32x16 acc[2]; acc[0] = f32x16{}; acc[1] = f32x16{};
        const bf16* Ap = Wsb + ((long)g * 128 + tb * 32 + r32) * 128 + hi * 8;
        const lds_cptr bp = (lds_cptr)shm + SG_B + (2 * ch) * 8192 + ((lane >> 4) & 1) * 32 + (lane & 3) * 8 + (8 * hi + ((lane & 15) >> 2)) * 64;
#pragma unroll
        for (int ks = 0; ks < 8; ++ks) { const bf16x8 af = *(const bf16x8*)(Ap + ks * 16);
#pragma unroll
            for (int cb = 0; cb < 2; ++cb) { const s16x4 lo = vtr(bp + cb * 8192 + ks * 1024), hh = vtr(bp + cb * 8192 + ks * 1024 + 256);
                const bf16x8 vf = (bf16x8){lo[0], lo[1], lo[2], lo[3], hh[0], hh[1], hh[2], hh[3]};
                acc[cb] = __builtin_amdgcn_mfma_f32_32x32x16_bf16(af, vf, acc[cb], 0, 0, 0); } }
#pragma unroll
        for (int r = 0; r < 16; ++r) { const int t = tb * 32 + crow(r, hi); const float bias = bs[g * 128 + t];
            bf16* up = GU + (row0 + t) * DM + g * 128 + ch * 64 + r32;
#pragma unroll
            for (int cb = 0; cb < 2; ++cb) { const float uu = __builtin_bit_cast(float, (unsigned)up[cb * 32] << 16); const float v = uu * (acc[cb][r] + bias); up[cb * 32] = (bf16)(cvtpk(v, v) & 0xffffu); } }
        __syncthreads();
    }
}
#undef ATT_WAIT_BAR
}

constexpr int NWAVES = 8, NTHR = 512;
#ifndef MK_N_LAUNCHES
#define MK_N_LAUNCHES 1
#endif
constexpr int N_LAUNCHES = MK_N_LAUNCHES;
constexpr int N_PHASES = 11;

constexpr int BATCH = 16, SEQ = 2048, D = 1024, T = BATCH * SEQ, NIN = 7 * D, NEXP = 32, DEXP = 256;
constexpr int NRB = T / 128;
constexpr int MAXTILES = (2 * T + NEXP * 255) / 256 + 1;
constexpr float EPS = 1e-6f;
constexpr size_t MiB = 1u << 20, KiB = 1u << 10;
constexpr size_t WS_CTL = 0, CTL_ZERO_BYTES = 1 * MiB;
constexpr size_t WS_MOD = 1 * MiB, WS_CB = 1 * MiB + 512 * KiB, WS_WR = 2 * MiB;
constexpr size_t WS_TOKE = 5 * MiB, WS_TOKW0 = WS_TOKE + 128 * KiB, WS_TOKW1 = WS_TOKE + 256 * KiB, WS_TOKR = WS_TOKE + 384 * KiB, WS_SLOT0 = WS_TOKE + 512 * KiB, WS_SLOT1 = WS_TOKE + 640 * KiB;
constexpr size_t WS_HIST = 6 * MiB, WS_WSB = 6 * MiB + 512 * KiB;
constexpr size_t WS_WIN = 8 * MiB, WS_WAP = 22 * MiB, WS_WSP = 24 * MiB, WS_WOUT = 26 * MiB, WS_WGU = 28 * MiB, WS_WD = 60 * MiB;
constexpr size_t WS_H = 80 * MiB, WS_Q = 144 * MiB, WS_K = 208 * MiB, WS_V = 272 * MiB, WS_U = 336 * MiB, WS_S = 400 * MiB;
constexpr size_t WS_Y = WS_H, WS_H2S = 144 * MiB, WS_ACT = 296 * MiB, WS_EO = 336 * MiB, WS_END = 480 * MiB;
static_assert(WS_H2S + (size_t)MAXTILES * 256 * D * 2 <= WS_ACT && WS_ACT + (size_t)MAXTILES * 256 * DEXP * 2 <= WS_EO && WS_EO + (size_t)MAXTILES * 256 * D * 2 <= WS_END, "MoE buffers");
constexpr int CW_TMO = 0, CW_BAR = 4096;
constexpr int RING_OFF = 0, RING_BYTES = 131072, LDSCTL_OFF = RING_BYTES, MISC_OFF = LDSCTL_OFF + 320, LT_NT = LDSCTL_OFF + 1024, LT_TBL = LDSCTL_OFF + 1040, LT_EBASE = LT_TBL + 320 * 4, LT_BEF = LT_EBASE + 36 * 4;
constexpr int LDS_BYTES = 147456;
static_assert(LT_BEF + 32 * 4 <= LDS_BYTES && att::ATT_LDS <= RING_BYTES && att::SG_LDS <= RING_BYTES, "LDS map");

#define GAS __attribute__((address_space(1)))
#define LAS __attribute__((address_space(3)))
typedef unsigned short bf16;
typedef unsigned v4u __attribute__((ext_vector_type(4)));
typedef unsigned v2u __attribute__((ext_vector_type(2)));
typedef float f32x4 __attribute__((ext_vector_type(4)));
typedef GAS unsigned gu32;
#define RLX_AGENT __ATOMIC_RELAXED, __HIP_MEMORY_SCOPE_AGENT
#define LDS_WAIT() asm volatile("s_waitcnt lgkmcnt(0)" ::: "memory")
#define VM_WAIT() asm volatile("s_waitcnt vmcnt(0)" ::: "memory")
__device__ __forceinline__ unsigned f2bf(float f) { unsigned u = __builtin_bit_cast(unsigned, f); return (u + 0x7fffu + ((u >> 16) & 1u)) >> 16; }
__device__ __forceinline__ unsigned pk2(float lo, float hi) { return f2bf(lo) | (f2bf(hi) << 16); }
__device__ __forceinline__ float wave_sum(float v) {
#pragma unroll
    for (int o = 1; o < 64; o <<= 1) v += __shfl_xor(v, o);
    return v;
}

#define XB_TMO      128
#define XB_XCNT(j)  (256  + 64 * (j))
#define XB_XSUB(j)  (1280 + 64 * (j))
#define XB_XGEN(j)  (2304 + 64 * (j))
#define XB_TOP      3328
#define XB_TOPGEN   3392
#define XCD_BAR_WORDS 3456
#define XB_SPIN_CAP (1u << 18)

__device__ __forceinline__ unsigned xb_ld(unsigned* p)              { return __hip_atomic_load(p, __ATOMIC_RELAXED, __HIP_MEMORY_SCOPE_AGENT); }
__device__ __forceinline__ unsigned xb_add(unsigned* p, unsigned v) { return __hip_atomic_fetch_add(p, v, __ATOMIC_RELAXED, __HIP_MEMORY_SCOPE_AGENT); }
__device__ __forceinline__ unsigned xb_xcc_id() { return (unsigned)__builtin_amdgcn_s_getreg((3 << 11) | 20) & 0xFu; }
#define XB_SPIN(cond, bar) do { unsigned _sp = 0; while (cond) { __builtin_amdgcn_s_sleep(1); \
    if ((++_sp & 255u) == 0u) { if (xb_ld(&(bar)[XB_TMO])) break; if (_sp > XB_SPIN_CAP) { atomicAdd(&(bar)[XB_TMO], 1u); break; } } } } while (0)

struct XcdBarrier {
    unsigned* bar; unsigned x;
    volatile LAS unsigned* st;
};

__device__ __forceinline__ XcdBarrier xcd_barrier_post(unsigned* bar, volatile LAS unsigned* st) {
    XcdBarrier b; b.bar = bar; b.x = xb_xcc_id(); b.st = st;
    if (threadIdx.x == 0) (void)xb_add(&bar[XB_XCNT(b.x)], 1u);
    return b;
}
__device__ __forceinline__ void xcd_barrier_complete(unsigned* bar, unsigned x, unsigned& nloc, unsigned& nx) {
    const unsigned G = gridDim.x * gridDim.y * gridDim.z;
    unsigned sum, cnt, mine, sp = 0u;
    for (;;) {
        sum = 0u; cnt = 0u; mine = 0u;
#pragma unroll
        for (unsigned j = 0; j < 16; ++j) { const unsigned c = xb_ld(&bar[XB_XCNT(j)]); sum += c; cnt += (c > 0u) ? 1u : 0u; mine = (j == x) ? c : mine; }
        if (sum == G) break;
        __builtin_amdgcn_s_sleep(1);
        if ((++sp & 255u) == 0u) { if (xb_ld(&bar[XB_TMO])) break; if (sp > XB_SPIN_CAP) { atomicAdd(&bar[XB_TMO], 1u); break; } }
    }
    nloc = mine > 0u ? mine : 1u; nx = cnt > 0u ? cnt : 1u;
}

__device__ __forceinline__ void xcd_barrier(const XcdBarrier& b) {
    asm volatile("s_waitcnt vmcnt(0)" ::: "memory");
    __syncthreads();
    if (threadIdx.x == 0) {
        unsigned* bar = b.bar;
        __builtin_amdgcn_s_waitcnt(0);
        unsigned nloc = b.st[0], nx = b.st[1];
        if (nloc == 0u) { xcd_barrier_complete(bar, b.x, nloc, nx); b.st[0] = nloc; b.st[1] = nx; }
        const unsigned old = xb_add(&bar[XB_XSUB(b.x)], 1u);
        const unsigned gen = old / nloc;
        if (old + 1u == (gen + 1u) * nloc) {
            __builtin_amdgcn_fence(__ATOMIC_RELEASE, "agent");
            asm volatile("s_waitcnt vmcnt(0)" ::: "memory");
            const unsigned og = xb_add(&bar[XB_TOP], 1u);
            const unsigned tg = og / nx;
            if (og + 1u == (tg + 1u) * nx) xb_add(&bar[XB_TOPGEN], 1u);
            else XB_SPIN(xb_ld(&bar[XB_TOPGEN]) == tg, bar);
            __builtin_amdgcn_fence(__ATOMIC_ACQUIRE, "agent");
            xb_add(&bar[XB_XGEN(b.x)], 1u);
            asm volatile("s_waitcnt vmcnt(0)" ::: "memory");
        } else {
            XB_SPIN(xb_ld(&bar[XB_XGEN(b.x)]) == gen, bar);
            __builtin_amdgcn_fence(__ATOMIC_ACQUIRE, "agent");
            asm volatile("s_waitcnt vmcnt(0)" ::: "memory");
        }
    }
    __syncthreads();
}


__device__ __forceinline__ void tr_item(const float* W, int N, bf16* WT, int Kd, int k0, int n0, int drow0, LAS float* scr, int lane) {
#pragma unroll 8
    for (int i = 0; i < 32; ++i) { const int kk = 2 * i + (lane >> 5); scr[kk * 33 + (lane & 31)] = W[(size_t)(k0 + kk) * N + n0 + (lane & 31)]; }
    LDS_WAIT(); asm volatile("" ::: "memory");
    const int c = lane & 7;
#pragma unroll
    for (int j = 0; j < 4; ++j) { const int n = (lane >> 3) + 8 * j; const LAS float* s = scr + (8 * c) * 33 + n;
        v4u o; o.x = pk2(s[0 * 33], s[1 * 33]); o.y = pk2(s[2 * 33], s[3 * 33]); o.z = pk2(s[4 * 33], s[5 * 33]); o.w = pk2(s[6 * 33], s[7 * 33]);
        *(v4u*)(WT + (size_t)(drow0 + n) * Kd + k0 + 8 * c) = o; }
    LDS_WAIT(); asm volatile("" ::: "memory");
}

struct Args { const float* in[26]; float* out; unsigned char* ws; int ph_lo, ph_hi, li, pad; };

__device__ __forceinline__ void p0_body(const Args& A, LAS unsigned char* lds, int tid, int lane, int wave, int bx, int G) {
    unsigned char* ws = A.ws;
    {
        LAS float* sc = (LAS float*)(lds + RING_OFF);
        LAS float* red = (LAS float*)(lds + RING_OFF + 65536);
        const float* c = A.in[1]; const float* w_ada = A.in[2]; const float* b_ada = A.in[3]; float* MOD = (float*)(ws + WS_MOD);
        for (int i = tid; i < BATCH * D; i += NTHR) { const float v = c[i]; sc[i] = v / (1.0f + __expf(-v)); }
        __syncthreads();
        for (int cw = bx; cw < 256; cw += G) {
            const int n0 = 24 * cw, kk = lane >> 3, cq = lane & 7;
            float acc[16][4];
#pragma unroll
            for (int b = 0; b < 16; ++b) { acc[b][0] = 0.f; acc[b][1] = 0.f; acc[b][2] = 0.f; acc[b][3] = 0.f; }
#pragma unroll 1
            for (int i = 0; i < 16; ++i) { const int k = 128 * wave + 8 * i + kk;
                f32x4 wv = {0.f, 0.f, 0.f, 0.f}; if (cq < 6) wv = *(const f32x4*)(w_ada + (size_t)k * (6 * D) + n0 + 4 * cq);
#pragma unroll
                for (int b = 0; b < 16; ++b) { const float s = sc[b * D + k]; acc[b][0] += s * wv[0]; acc[b][1] += s * wv[1]; acc[b][2] += s * wv[2]; acc[b][3] += s * wv[3]; } }
#pragma unroll
            for (int b = 0; b < 16; ++b)
#pragma unroll
                for (int j = 0; j < 4; ++j) { float v = acc[b][j]; v += __shfl_xor(v, 8); v += __shfl_xor(v, 16); v += __shfl_xor(v, 32); acc[b][j] = v; }
            if (lane < 8) {
#pragma unroll
                for (int b = 0; b < 16; ++b)
#pragma unroll
                    for (int j = 0; j < 4; ++j) red[(wave * 16 + b) * 32 + 4 * cq + j] = acc[b][j]; }
            __syncthreads();
            if (tid < 16 * 24) { const int b = tid / 24, col = tid % 24; float s = b_ada[n0 + col];
#pragma unroll
                for (int w = 0; w < 8; ++w) s += red[(w * 16 + b) * 32 + col];
                MOD[(size_t)b * (6 * D) + n0 + col] = s; }
            __syncthreads();
        }
    }
    LAS float* scr = (LAS float*)(lds + RING_OFF + wave * 16384);
    const int gw = bx * NWAVES + wave, NGW = G * NWAVES;
    bf16* Win_t = (bf16*)(ws + WS_WIN); bf16* Wap_t = (bf16*)(ws + WS_WAP); bf16* Wsp_t = (bf16*)(ws + WS_WSP); bf16* Wout_t = (bf16*)(ws + WS_WOUT); bf16* Wgu_t = (bf16*)(ws + WS_WGU); bf16* Wd_t = (bf16*)(ws + WS_WD);
    constexpr int I_IN = 16 * 224, I_SQ = 16 * 32, I_GU = NEXP * 16 * 16, I_DN = NEXP * 4 * 32, NITEMS = I_IN + 3 * I_SQ + I_GU + I_DN;
    for (int it = gw; it < NITEMS; it += NGW) {
        int r = it; const float* W; bf16* WT; int N, Kd, k0, n0, dr;
        if (r < I_IN) { const int kb = r / 224, nb = r % 224; W = A.in[5]; N = NIN; WT = Win_t; Kd = D; k0 = 64 * kb; n0 = 32 * nb; dr = n0; }
        else if ((r -= I_IN) < 3 * I_SQ) { const int which = r / I_SQ, rr = r % I_SQ, kb = rr / 32, nb = rr % 32;
            W = which == 0 ? A.in[11] : (which == 1 ? A.in[16] : A.in[17]); WT = which == 0 ? Wap_t : (which == 1 ? Wsp_t : Wout_t); N = D; Kd = D; k0 = 64 * kb; n0 = 32 * nb; dr = n0; }
        else if ((r -= 3 * I_SQ) < I_GU) { const int e = r / 256, rr = r % 256, kb = rr / 16, nb = rr % 16, bj = (32 * nb) >> 8, wi = (32 * nb) & 255, j = wi >> 7, cc = wi & 127;
            W = A.in[23] + (size_t)e * D * 512; N = 512; WT = Wgu_t; Kd = D; k0 = 64 * kb; n0 = 32 * nb; dr = e * 512 + j * 256 + bj * 128 + cc; }
        else { r -= I_GU; const int e = r / 128, rr = r % 128, kb = rr / 32, nb = rr % 32;
            W = A.in[24] + (size_t)e * DEXP * D; N = D; WT = Wd_t; Kd = DEXP; k0 = 64 * kb; n0 = 32 * nb; dr = e * D + n0; }
        tr_item(W, N, WT, Kd, k0, n0, dr, scr, lane);
    }
    { const float* wsrc = A.in[14]; unsigned* wdst = (unsigned*)(ws + WS_WSB);
        for (int i = bx * NTHR + tid; i < 8 * 128 * 128 / 2; i += G * NTHR) wdst[i] = pk2(wsrc[2 * i], wsrc[2 * i + 1]); }
}

__device__ __forceinline__ void p1_body(const Args& A, LAS unsigned char* lds, int tid, int lane, int wave, int bx, int G) {
    unsigned char* ws = A.ws;
    const float* MOD = (const float*)(ws + WS_MOD); const float* x = A.in[0]; const float* g1 = A.in[4]; bf16* H = (bf16*)(ws + WS_H);
    for (int rb = bx; rb < NRB; rb += G) {
        const int b = rb / 16; const float* mb = MOD + (size_t)b * (6 * D);
        f32x4 a1[4], s1[4];
#pragma unroll
        for (int j = 0; j < 4; ++j) { const int d = 4 * lane + 256 * j; const f32x4 gv = *(const f32x4*)(g1 + d), sv = *(const f32x4*)(mb + D + d); a1[j] = gv * (sv + 1.0f); s1[j] = *(const f32x4*)(mb + d); }
        for (int i = 0; i < 16; ++i) { const size_t t = (size_t)rb * 128 + wave * 16 + i;
            f32x4 v[4]; float ss = 0.f;
#pragma unroll
            for (int j = 0; j < 4; ++j) { v[j] = *(const f32x4*)(x + t * D + 4 * lane + 256 * j); ss += (v[j][0] * v[j][0] + v[j][1] * v[j][1]) + (v[j][2] * v[j][2] + v[j][3] * v[j][3]); }
            const float rstd = __builtin_amdgcn_rsqf(wave_sum(ss) * (1.0f / D) + EPS);
#pragma unroll
            for (int j = 0; j < 4; ++j) { const f32x4 h = v[j] * rstd * a1[j] + s1[j]; v2u o; o.x = pk2(h[0], h[1]); o.y = pk2(h[2], h[3]); *(v2u*)(H + t * D + 4 * lane + 256 * j) = o; }
        }
    }
    const float* g2 = A.in[18]; const float* w_rg = A.in[19]; const float* b_rg = A.in[20]; const float* w_re = A.in[21]; const float* b_re = A.in[22];
    float* WR = (float*)(ws + WS_WR); float* CB = (float*)(ws + WS_CB);
    LAS float* red = (LAS float*)(lds + RING_OFF);
    for (int item = bx; item < 256; item += G) { const int b = item / 16, part = item % 16; const float* mb = MOD + (size_t)b * (6 * D);
        for (int ee = 0; ee < 3; ++ee) { const int e = 3 * part + ee; float cp = 0.f;
            for (int d = tid; d < D; d += NTHR) { const float wr = e < 32 ? w_re[d * 32 + e] : (e < 36 ? w_rg[d * 4 + (e - 32)] : 0.f);
                WR[((size_t)b * 48 + e) * D + d] = g2[d] * (1.0f + mb[4 * D + d]) * wr; cp += mb[3 * D + d] * wr; }
            cp = wave_sum(cp); if (lane == 0) red[wave] = cp;
            __syncthreads();
            if (tid == 0) { float s = e < 32 ? b_re[e] : (e < 36 ? b_rg[e - 32] : 0.f);
#pragma unroll
                for (int w = 0; w < 8; ++w) s += red[w];
                CB[b * 48 + e] = s; }
            __syncthreads(); }
    }
}

typedef float f32x4m __attribute__((ext_vector_type(4)));
__device__ __forceinline__ void p6a_body(const Args& A, LAS unsigned char* lds, int tid, int lane, int wave, int bx, int G) {
    unsigned char* ws = A.ws;
    const float* X1 = A.out; const float* WR = (const float*)(ws + WS_WR); const float* CB = (const float*)(ws + WS_CB);
    int* TOKE = (int*)(ws + WS_TOKE); float* TOKW0 = (float*)(ws + WS_TOKW0); float* TOKW1 = (float*)(ws + WS_TOKW1); float* TOKR = (float*)(ws + WS_TOKR); int* HIST = (int*)(ws + WS_HIST);
    LAS int* hist = (LAS int*)(lds + RING_OFF);
    LAS float* lg = (LAS float*)(lds + RING_OFF + 1024) + wave * (16 * 48);
    for (int rb = bx; rb < NRB; rb += G) {
        if (tid < 32) hist[tid] = 0;
        __syncthreads();
        const int b = rb / 16, row = lane & 15, kq = lane >> 4; const size_t t0 = (size_t)rb * 128 + wave * 16;
        const float* xp = X1 + (t0 + row) * D + 4 * kq; const float* wp = WR + ((size_t)b * 48 + row) * D + 4 * kq;
        f32x4m acc0 = {0.f, 0.f, 0.f, 0.f}, acc1 = acc0, acc2 = acc0; float ss = 0.f;
#pragma unroll 4
        for (int j = 0; j < 64; ++j) {
            const f32x4 xa = *(const f32x4*)(xp + 16 * j), w0 = *(const f32x4*)(wp + 16 * j), w1 = *(const f32x4*)(wp + 16 * D + 16 * j), w2 = *(const f32x4*)(wp + 32 * D + 16 * j);
            ss += (xa[0] * xa[0] + xa[1] * xa[1]) + (xa[2] * xa[2] + xa[3] * xa[3]);
#pragma unroll
            for (int i = 0; i < 4; ++i) { acc0 = __builtin_amdgcn_mfma_f32_16x16x4f32(xa[i], w0[i], acc0, 0, 0, 0); acc1 = __builtin_amdgcn_mfma_f32_16x16x4f32(xa[i], w1[i], acc1, 0, 0, 0); acc2 = __builtin_amdgcn_mfma_f32_16x16x4f32(xa[i], w2[i], acc2, 0, 0, 0); }
        }
        ss += __shfl_xor(ss, 16); ss += __shfl_xor(ss, 32);
        const float rstd = __builtin_amdgcn_rsqf(ss * (1.0f / D) + EPS);
#pragma unroll
        for (int i = 0; i < 4; ++i) { const int r = 4 * kq + i; lg[r * 48 + row] = acc0[i]; lg[r * 48 + 16 + row] = acc1[i]; lg[r * 48 + 32 + row] = acc2[i]; }
        LDS_WAIT(); asm volatile("" ::: "memory");
        if (lane < 16) {
            const LAS float* lp = lg + lane * 48; const float* cb = CB + b * 48;
            float gl[4];
#pragma unroll
            for (int i = 0; i < 4; ++i) gl[i] = rstd * lp[32 + i] + cb[32 + i];
            int gi = 0; float gm = gl[0];
#pragma unroll
            for (int i = 1; i < 4; ++i) if (gl[i] > gm) { gm = gl[i]; gi = i; }
            float gs = 0.f;
#pragma unroll
            for (int i = 0; i < 4; ++i) gs += __expf(gl[i] - gm);
            const float gval = 1.0f / gs;
            float el[8];
#pragma unroll
            for (int i = 0; i < 8; ++i) el[i] = rstd * lp[8 * gi + i] + cb[8 * gi + i];
            int e0 = 0; float m0 = el[0];
#pragma unroll
            for (int i = 1; i < 8; ++i) if (el[i] > m0) { m0 = el[i]; e0 = i; }
            int e1 = -1; float m1 = -3.0e38f;
#pragma unroll
            for (int i = 0; i < 8; ++i) if (i != e0 && el[i] > m1) { m1 = el[i]; e1 = i; }
            const float a1 = __expf(m1 - m0), inv = gval / (1.0f + a1);
            const size_t t = t0 + lane; const int ge0 = 8 * gi + e0, ge1 = 8 * gi + e1;
            TOKE[t] = ge0 | (ge1 << 8); TOKW0[t] = inv; TOKW1[t] = inv * a1; TOKR[t] = rstd;
            __hip_atomic_fetch_add(hist + ge0, 1, __ATOMIC_RELAXED, __HIP_MEMORY_SCOPE_WORKGROUP); __hip_atomic_fetch_add(hist + ge1, 1, __ATOMIC_RELAXED, __HIP_MEMORY_SCOPE_WORKGROUP);
        }
        __syncthreads();
        if (tid < 32) HIST[rb * 32 + tid] = hist[tid];
        __syncthreads();
    }
}

__device__ __forceinline__ void moe_table(const int* HIST, int rb, LAS unsigned char* lds, int tid) {
    LAS int* sc = (LAS int*)(lds + RING_OFF + 65536);
    LAS int* ebase = (LAS int*)(lds + LT_EBASE); LAS int* bef = (LAS int*)(lds + LT_BEF); LAS int* ntl = (LAS int*)(lds + LT_NT); LAS int* tbl = (LAS int*)(lds + LT_TBL);
    { const int e = tid & 31, part = tid >> 5; int st = 0, sb = 0;
        for (int j = 0; j < 16; ++j) { const int r = part * 16 + j; const int v = HIST[r * 32 + e]; st += v; sb += (r < rb) ? v : 0; }
        sc[part * 32 + e] = st; sc[512 + part * 32 + e] = sb; }
    __syncthreads();
    if (tid < 32) { int tot = 0, b = 0;
        for (int p = 0; p < 16; ++p) { tot += sc[p * 32 + tid]; b += sc[512 + p * 32 + tid]; }
        bef[tid] = b; sc[1024 + tid] = tot; }
    __syncthreads();
    if (tid == 0) { int base = 0, nt = 0;
        for (int e = 0; e < NEXP; ++e) { ebase[e] = base; const int n = (sc[1024 + e] + 255) >> 8; for (int k = 0; k < n; ++k) tbl[nt + k] = e; nt += n; base += n * 256; }
        ebase[NEXP] = base; *ntl = nt; }
    __syncthreads();
}

__device__ __forceinline__ void p6b_body(const Args& A, LAS unsigned char* lds, int tid, int lane, int wave, int bx, int G) {
    unsigned char* ws = A.ws;
    const float* X1 = A.out; const float* MOD = (const float*)(ws + WS_MOD); const float* g2 = A.in[18];
    const int* TOKE = (const int*)(ws + WS_TOKE); const float* TOKR = (const float*)(ws + WS_TOKR); int* SLOT0 = (int*)(ws + WS_SLOT0); int* SLOT1 = (int*)(ws + WS_SLOT1); const int* HIST = (const int*)(ws + WS_HIST);
    bf16* H2S = (bf16*)(ws + WS_H2S);
    LAS int* te = (LAS int*)(lds + RING_OFF); LAS int* sl = (LAS int*)(lds + RING_OFF + 1024);
    LAS int* ebase = (LAS int*)(lds + LT_EBASE); LAS int* bef = (LAS int*)(lds + LT_BEF);
    for (int rb = bx; rb < NRB; rb += G) {
        moe_table(HIST, rb, lds, tid);
        if (tid < 128) te[tid] = TOKE[rb * 128 + tid];
        __syncthreads();
        if (tid < 128) { const int me = te[tid], e0 = me & 255, e1 = me >> 8; int r0 = 0, r1 = 0;
            for (int j = 0; j < tid; ++j) { const int o = te[j], a = o & 255, c = o >> 8; r0 += (a == e0) + (c == e0); r1 += (a == e1) + (c == e1); }
            const int s0 = ebase[e0] + bef[e0] + r0, s1 = ebase[e1] + bef[e1] + r1;
            SLOT0[rb * 128 + tid] = s0; SLOT1[rb * 128 + tid] = s1; sl[2 * tid] = s0; sl[2 * tid + 1] = s1; }
        __syncthreads();
        const int b = rb / 16; const float* mb = MOD + (size_t)b * (6 * D);
        f32x4 a2[4], s2[4];
#pragma unroll
        for (int j = 0; j < 4; ++j) { const int d = 4 * lane + 256 * j; const f32x4 gv = *(const f32x4*)(g2 + d), sv = *(const f32x4*)(mb + 4 * D + d); a2[j] = gv * (sv + 1.0f); s2[j] = *(const f32x4*)(mb + 3 * D + d); }
        for (int i = 0; i < 16; ++i) { const int row = wave * 16 + i; const size_t t = (size_t)rb * 128 + row;
            const float rstd = TOKR[t]; const size_t o0 = (size_t)sl[2 * row] * D, o1 = (size_t)sl[2 * row + 1] * D;
#pragma unroll
            for (int j = 0; j < 4; ++j) { const f32x4 v = *(const f32x4*)(X1 + t * D + 4 * lane + 256 * j); const f32x4 h = v * rstd * a2[j] + s2[j];
                v2u o; o.x = pk2(h[0], h[1]); o.y = pk2(h[2], h[3]); *(v2u*)(H2S + o0 + 4 * lane + 256 * j) = o; *(v2u*)(H2S + o1 + 4 * lane + 256 * j) = o; }
        }
        __syncthreads();
    }
}

__device__ __forceinline__ void p8_body(const Args& A, int tid, int lane, int wave, int bx, int G) {
    unsigned char* ws = A.ws;
    float* X1 = A.out; const float* MOD = (const float*)(ws + WS_MOD); const float* fg = A.in[25];
    const float* TOKW0 = (const float*)(ws + WS_TOKW0); const float* TOKW1 = (const float*)(ws + WS_TOKW1); const int* SLOT0 = (const int*)(ws + WS_SLOT0); const int* SLOT1 = (const int*)(ws + WS_SLOT1);
    const bf16* EO = (const bf16*)(ws + WS_EO);
    for (int rb = bx; rb < NRB; rb += G) {
        const int b = rb / 16; const float* mb = MOD + (size_t)b * (6 * D);
        f32x4 gt[4], fgv[4];
#pragma unroll
        for (int j = 0; j < 4; ++j) { const int d = 4 * lane + 256 * j; gt[j] = *(const f32x4*)(mb + 5 * D + d); fgv[j] = *(const f32x4*)(fg + d); }
        for (int i = 0; i < 16; ++i) { const size_t t = (size_t)rb * 128 + wave * 16 + i;
            const float w0 = TOKW0[t], w1 = TOKW1[t]; const size_t o0 = (size_t)SLOT0[t] * D, o1 = (size_t)SLOT1[t] * D;
            f32x4 v[4]; float ss = 0.f;
#pragma unroll
            for (int j = 0; j < 4; ++j) { const int d = 4 * lane + 256 * j; const f32x4 xv = *(const f32x4*)(X1 + t * D + d);
                const v2u ea = *(const v2u*)(EO + o0 + d), eb = *(const v2u*)(EO + o1 + d);
                f32x4 y = {w0 * pg8::bf_lo(ea.x) + w1 * pg8::bf_lo(eb.x), w0 * pg8::bf_hi(ea.x) + w1 * pg8::bf_hi(eb.x), w0 * pg8::bf_lo(ea.y) + w1 * pg8::bf_lo(eb.y), w0 * pg8::bf_hi(ea.y) + w1 * pg8::bf_hi(eb.y)};
                v[j] = xv + gt[j] * y; ss += (v[j][0] * v[j][0] + v[j][1] * v[j][1]) + (v[j][2] * v[j][2] + v[j][3] * v[j][3]); }
            const float rstd = __builtin_amdgcn_rsqf(wave_sum(ss) * (1.0f / D) + EPS);
#pragma unroll
            for (int j = 0; j < 4; ++j) *(f32x4*)(X1 + t * D + 4 * lane + 256 * j) = v[j] * rstd * fgv[j];
        }
    }
}

__global__ void __launch_bounds__(NTHR, 2) fwd(Args args) {
    extern __shared__ __attribute__((aligned(16))) unsigned char lds_raw[];
    LAS unsigned char* lds = (LAS unsigned char*)lds_raw;
    const int tid = threadIdx.x, lane = tid & 63, wave = __builtin_amdgcn_readfirstlane(tid >> 6);
    const int G = gridDim.x, bx = blockIdx.x, vcu = (G % 8 == 0) ? (bx % 8) * (G / 8) + bx / 8 : bx;
    unsigned char* ws = args.ws;
    gu32* ctl = (gu32*)(ws + WS_CTL);
    volatile LAS unsigned* MISC = (volatile LAS unsigned*)(lds + MISC_OFF);
    for (int u = tid; u < (LDS_BYTES - LDSCTL_OFF) / 4; u += NTHR) ((LAS unsigned*)(lds + LDSCTL_OFF))[u] = 0u;
    __syncthreads();
    XcdBarrier bar = xcd_barrier_post((unsigned*)(ctl + CW_BAR) + args.li * XCD_BAR_WORDS, MISC + 8);
    const int lo = args.ph_lo, hi = args.ph_hi;
#ifndef PH_MASK
#define PH_MASK 0x7ff
#endif
#define IN(k) ((((PH_MASK) >> (k)) & 1) && lo <= (k) && (k) < hi)
#define SEAM(k) do { if (IN(k) && IN((k) + 1)) xcd_barrier(bar); } while (0)
    bf16* Hb = (bf16*)(ws + WS_H); bf16* Qb = (bf16*)(ws + WS_Q); bf16* Kb = (bf16*)(ws + WS_K); bf16* Vb = (bf16*)(ws + WS_V); bf16* Ub = (bf16*)(ws + WS_U); bf16* Sb = (bf16*)(ws + WS_S);
    bf16* GAb = (bf16*)args.out; bf16* GBb = GAb + (size_t)T * D; bf16* Yb = (bf16*)(ws + WS_Y);
    const float* MOD = (const float*)(ws + WS_MOD);

    if (IN(0)) { p0_body(args, lds, tid, lane, wave, bx, G); } SEAM(0);
    if (IN(1)) { p1_body(args, lds, tid, lane, wave, bx, G); } SEAM(1);
    if (IN(2)) {
        pg8::Gemm g{Hb, (const bf16*)(ws + WS_WIN), T, NIN, D}; pg8::StaticOrder S; S.init(T, NIN, G, bx);
        pg8::EpiIn E{Qb, GAb, (size_t)T * D, 0.125f * 1.4426950408889634f};
        pg8::gemm_phase<pg8::EpiIn, pg8::StaticOrder, true, true>(lds + RING_OFF, g, S, E);
    } SEAM(2);
    if (IN(3)) {
        float lam;
        { const float a = args.in[6][lane] * args.in[7][lane], c = args.in[8][lane] * args.in[9][lane]; lam = __expf(wave_sum(a)) - __expf(wave_sum(c)) + 0.2f; }
        for (int i = 0;; ++i) { const int U = i * G + vcu; if (U >= BATCH * 8 * 16) break;
            const int bh = U >> 4, qb = U & 15, b = bh >> 3, h = bh & 7;
            const float slope2 = __builtin_amdgcn_exp2f(-(float)(h + 1)) * 1.4426950408889634f;
            att::attn_unit(b, h, qb, Qb, Kb, Vb, Qb, (char*)lds_raw + RING_OFF, lam, slope2, args.in[10], 0.8f); }
        for (int u = vcu; u < NRB; u += G)
            att::sgu_unit(u >> 4, u & 15, Sb, Ub, (const bf16*)(ws + WS_WSB), args.in[15], args.in[12], args.in[13], (char*)lds_raw + RING_OFF);
    } SEAM(3);
    if (IN(4)) {
        pg8::StaticOrder S; S.init(T, D, G, bx);
        { pg8::Gemm g{Qb, (const bf16*)(ws + WS_WAP), T, D, D}; pg8::EpiGate<true> E{GAb, Yb};
          pg8::gemm_phase<pg8::EpiGate<true>, pg8::StaticOrder, true, true>(lds + RING_OFF, g, S, E); }
        VM_WAIT(); __syncthreads();
        { pg8::Gemm g{Ub, (const bf16*)(ws + WS_WSP), T, D, D}; pg8::EpiGate<false> E{GBb, Yb};
          pg8::gemm_phase<pg8::EpiGate<false>, pg8::StaticOrder, true, true>(lds + RING_OFF, g, S, E); }
    } SEAM(4);
    if (IN(5)) {
        pg8::Gemm g{Yb, (const bf16*)(ws + WS_WOUT), T, D, D}; pg8::StaticOrder S; S.init(T, D, G, bx);
        pg8::EpiRes E{args.in[0], args.out, MOD + 2 * D, 6 * D, SEQ};
        pg8::gemm_phase<pg8::EpiRes, pg8::StaticOrder, true, true>(lds + RING_OFF, g, S, E);
    } SEAM(5);
    if (IN(6)) { p6a_body(args, lds, tid, lane, wave, bx, G); } SEAM(6);
    if (IN(7)) { p6b_body(args, lds, tid, lane, wave, bx, G); } SEAM(7);
    if (IN(8)) {
        moe_table((const int*)(ws + WS_HIST), 0, lds, tid);
        pg8::Gemm g{(const bf16*)(ws + WS_H2S), (const bf16*)(ws + WS_WGU), 0, 0, D};
        pg8::MoeOrder<2> S{(const volatile LAS int*)(lds + LT_TBL), *(volatile LAS int*)(lds + LT_NT), G, vcu};
        pg8::EpiGU E{(bf16*)(ws + WS_ACT)};
        pg8::gemm_phase<pg8::EpiGU, pg8::MoeOrder<2>, true, true>(lds + RING_OFF, g, S, E);
    } SEAM(8);
    if (IN(9)) {
        moe_table((const int*)(ws + WS_HIST), 0, lds, tid);
        int kdn = DEXP; asm volatile("" : "+s"(kdn));
        pg8::Gemm g{(const bf16*)(ws + WS_ACT), (const bf16*)(ws + WS_WD), 0, 0, kdn};
        pg8::MoeOrder<4> S{(const volatile LAS int*)(lds + LT_TBL), *(volatile LAS int*)(lds + LT_NT), G, vcu};
        pg8::EpiDown E{(bf16*)(ws + WS_EO)};
        pg8::gemm_phase<pg8::EpiDown, pg8::MoeOrder<4>, true, true>(lds + RING_OFF, g, S, E);
    } SEAM(9);
    if (IN(10)) { p8_body(args, tid, lane, wave, bx, G); }
#undef IN
#undef SEAM
}

extern "C" void kernel_launch(void* const* d_in, const int* in_sizes, int n_in, void* d_out, int out_size, void* d_ws, size_t ws_size, hipStream_t stream) {
    static int grid = 0;
    if (grid == 0) {
        if (n_in != 26 || in_sizes[0] != T * D || out_size != T * D || ws_size < WS_END) { fprintf(stderr, "kernel_launch: unexpected shapes (n_in %d, in0 %d, out %d, ws %zu); nothing launched\n", n_in, n_in > 0 ? in_sizes[0] : -1, out_size, ws_size); grid = -1; return; }
        int dev = 0, cus = 0, per_cu = 0;
        if (hipGetDevice(&dev) != hipSuccess || hipDeviceGetAttribute(&cus, hipDeviceAttributeMultiprocessorCount, dev) != hipSuccess) { grid = -1; return; }
        if (hipFuncSetAttribute((const void*)fwd, hipFuncAttributeMaxDynamicSharedMemorySize, LDS_BYTES) != hipSuccess) { fprintf(stderr, "kernel_launch: hipFuncSetAttribute failed\n"); grid = -1; return; }
        if (hipOccupancyMaxActiveBlocksPerMultiprocessor(&per_cu, (const void*)fwd, NTHR, LDS_BYTES) != hipSuccess || per_cu < 1) { fprintf(stderr, "kernel_launch: occupancy query reports %d workgroups per CU\n", per_cu); }
        (void)hipGetLastError();
        grid = cus;
    }
    if (grid < 0) return;
    (void)hipMemsetAsync((char*)d_ws + WS_CTL, 0, CTL_ZERO_BYTES, stream);
    Args a{};
    for (int i = 0; i < 26; ++i) a.in[i] = (const float*)d_in[i];
    a.out = (float*)d_out; a.ws = (unsigned char*)d_ws; a.pad = 0;
    if (N_LAUNCHES == 1) { a.ph_lo = 0; a.ph_hi = N_PHASES; a.li = 0; hipLaunchKernelGGL(fwd, dim3(grid), dim3(NTHR), LDS_BYTES, stream, a); }
    else { for (int li = 0; li < N_PHASES; ++li) { a.ph_lo = li; a.ph_hi = li + 1; a.li = li; hipLaunchKernelGGL(fwd, dim3(grid), dim3(NTHR), LDS_BYTES, stream, a); } }
}
```

```cpp
#include <hip/hip_runtime.h>
#include <hip/hip_bf16.h>
#include <cstdio>
#include <cstdint>
namespace pg8 {
#define PG8_LAS __attribute__((address_space(3)))
typedef unsigned short bf16_t;
typedef short bf16x8 __attribute__((ext_vector_type(8)));
typedef float f32x4 __attribute__((ext_vector_type(4)));
typedef unsigned u32x4 __attribute__((ext_vector_type(4)));
constexpr int BM = 256, BK = 64, HALF = 128, HTB = HALF * BK * 2  , STAGE_BYTES = 8 * HTB, NXCD = 8, WGM = 8;

__host__ __device__ __forceinline__ int lds_byte(int r, int c) { const int st = (r >> 4) * 2 + (c >> 5), rr = r & 15, cc = c & 31, ob = rr * 64 + cc * 2; return st * 1024 + (ob ^ (((ob >> 9) & 1) << 5)); }
__host__ __device__ __forceinline__ void stage_rc(int b, int& R, int& C) { const int st = b / 1024, sb = b % 1024, swz = sb ^ (((sb >> 9) & 1) << 5); R = (st >> 1) * 16 + swz / 64; C = (st & 1) * 32 + (swz % 64) / 2; }
__host__ __device__ __forceinline__ int perm32(int rho) { const int n = rho >> 4, i = rho & 15; return 8 * (i >> 2) + 4 * n + (i & 3); }

struct Unit { int pm, pn; };
struct Gemm { const bf16_t* A; const bf16_t* Bt; int M, N, K; };

struct StaticOrder {
    int nM, nN, nwg, G, c;
    __host__ __device__ void init(int M, int N, int G_, int c_) { nM = M / BM; nN = N / BM; nwg = nM * nN; G = G_; c = c_; }
    __host__ __device__ bool next(int i, Unit& u) const {
        const long L = (long)i * G + c; if (L >= nwg) return false;
        int wgid = (int)L; { const int q = nwg / NXCD, r = nwg % NXCD, xcd = wgid % NXCD, off = wgid / NXCD; wgid = (xcd < r ? xcd * (q + 1) : r * (q + 1) + (xcd - r) * q) + off; }
        const int nig = WGM * nN, gid = wgid / nig, fm = gid * WGM, gsz = (nM - fm) < WGM ? (nM - fm) : WGM;
        u.pm = fm + ((wgid % nig) % gsz); u.pn = (wgid % nig) / gsz; return true;
    }
    __device__ __forceinline__ void a_ready(const Unit&) const {}
    __device__ __forceinline__ void done(const Unit&) const {}
};

__device__ __forceinline__ unsigned cvt_pk_bf16(float lo, float hi) { unsigned r; asm volatile("v_cvt_pk_bf16_f32 %0, %1, %2" : "=v"(r) : "v"(lo), "v"(hi)); return r; }
typedef float f32x2 __attribute__((ext_vector_type(2)));

template <class Epi, class Sched, bool ALIGN_EPI = false, bool SP2 = false>
__device__ __forceinline__ void gemm_phase(PG8_LAS unsigned char* lds, const Gemm g, const Sched& S, const Epi& E) {
    const int tid = threadIdx.x, wid = __builtin_amdgcn_readfirstlane(tid >> 6), lane = tid & 63, wr = wid >> 2, wc = wid & 3, fr = lane & 15, fq = lane >> 4;
    const int K = g.K, nt = K / BK;
    unsigned voffA[2], voffB[2];
#pragma unroll
    for (int i = 0; i < 2; ++i) { int R, C; stage_rc(tid * 16 + i * 8192, R, C); const int Rb = Epi::PERM ? ((R & ~31) + perm32(R & 31)) : R;
        voffA[i] = (unsigned)(R * K + C) * 2u; voffB[i] = (unsigned)(Rb * K + C) * 2u; }
    const size_t kstep = (size_t)(BK * 2);
    const size_t hstep = (size_t)HALF * K * 2;
    const size_t tstep = 2 * hstep;
    const unsigned ldsw = (unsigned)wid * 1024u;
    const int aoff = lds_byte(wr * 64 + fr, fq * 8), boff = lds_byte(wc * 32 + fr, fq * 8);
#define PG8_SA(b, h) (((b) * 2 + (h)) * HTB)
#define PG8_SB(b, h) ((4 + (b) * 2 + (h)) * HTB)
#define PG8_STAGE(bufoff, gbase, voff) do { _Pragma("unroll") for (int _i = 0; _i < 2; ++_i) \
        __builtin_amdgcn_global_load_lds((const unsigned*)((const char*)(gbase) + (voff)[_i]), (PG8_LAS unsigned*)(lds + (bufoff) + ldsw + _i * 8192), 16, 0, 0); } while (0)
#define PG8_LDA(dst, b, h) do { _Pragma("unroll") for (int m = 0; m < 4; ++m) _Pragma("unroll") for (int k = 0; k < 2; ++k) dst[m][k] = *(const PG8_LAS bf16x8*)(lds + PG8_SA(b, h) + aoff + m * 2048 + k * 1024); } while (0)
#define PG8_LDB(dst, b, h) do { _Pragma("unroll") for (int n = 0; n < 2; ++n) _Pragma("unroll") for (int k = 0; k < 2; ++k) dst[n][k] = *(const PG8_LAS bf16x8*)(lds + PG8_SB(b, h) + boff + n * 2048 + k * 1024); } while (0)
#define PG8_MMA(ai, bj, At, Bt) do { __builtin_amdgcn_s_setprio(1); _Pragma("unroll") for (int m = 0; m < 4; ++m) _Pragma("unroll") for (int n = 0; n < 2; ++n) _Pragma("unroll") for (int k = 0; k < 2; ++k) \
        acc[ai][bj][m][n] = __builtin_amdgcn_mfma_f32_16x16x32_bf16(Bt[n][k], At[m][k], acc[ai][bj][m][n], 0, 0, 0); __builtin_amdgcn_s_setprio(0); } while (0)
#define PG8_WAIT_V(n) asm volatile("s_waitcnt vmcnt(" #n ")" ::: "memory")
#define PG8_WAIT_L(n) asm volatile("s_waitcnt lgkmcnt(" #n ")" ::: "memory")
#define PG8_BAR __builtin_amdgcn_s_barrier()
#define PG8_SCHED __builtin_amdgcn_sched_barrier(0)
    Unit cur, nxt; int ui = 0;
    if (!S.next(0, cur)) return;
    f32x4 acc[2][2][4][2];
#pragma unroll
    for (int a = 0; a < 2; ++a)
#pragma unroll
        for (int b = 0; b < 2; ++b)
#pragma unroll
            for (int m = 0; m < 4; ++m)
#pragma unroll
                for (int n = 0; n < 2; ++n) acc[a][b][m][n] = (f32x4){0.f, 0.f, 0.f, 0.f};
    bf16x8 At[4][2], B0[2][2], B1[2][2];
    const char* cA = (const char*)g.A + (size_t)cur.pm * tstep; const char* cB = (const char*)g.Bt + (size_t)cur.pn * tstep;
    S.a_ready(cur);
    if constexpr (SP2) {
        PG8_STAGE(PG8_SB(0, 0), cB, voffB); PG8_STAGE(PG8_SB(0, 1), cB + hstep, voffB); PG8_STAGE(PG8_SA(0, 0), cA, voffA); PG8_STAGE(PG8_SA(0, 1), cA + hstep, voffA);
        if (wr == 1) PG8_BAR;
        PG8_WAIT_V(2); PG8_BAR;
        PG8_STAGE(PG8_SB(1, 0), cB + kstep, voffB); PG8_STAGE(PG8_SA(1, 0), cA + kstep, voffA); PG8_STAGE(PG8_SB(1, 1), cB + hstep + kstep, voffB);
        PG8_WAIT_V(6); PG8_BAR;
    } else {
        PG8_STAGE(PG8_SB(0, 0), cB, voffB); PG8_STAGE(PG8_SA(0, 0), cA, voffA); PG8_STAGE(PG8_SB(0, 1), cB + hstep, voffB); PG8_STAGE(PG8_SA(0, 1), cA + hstep, voffA);
        if (wr == 1) PG8_BAR;
        PG8_WAIT_V(4); PG8_BAR;
        PG8_STAGE(PG8_SB(1, 0), cB + kstep, voffB); PG8_STAGE(PG8_SA(1, 0), cA + kstep, voffA); PG8_STAGE(PG8_SB(1, 1), cB + hstep + kstep, voffB);
        PG8_WAIT_V(6); PG8_BAR;
    }
    for (;;) {
        const bool has_next = S.next(ui + 1, nxt);
        const char* nA = has_next ? (const char*)g.A + (size_t)nxt.pm * tstep : cA; const char* nB = has_next ? (const char*)g.Bt + (size_t)nxt.pn * tstep : cB;
        for (int t = 0; t < nt; t += 2) {
            const bool last = (t == nt - 2);
            const char* a1 = cA + (size_t)(t + 1) * kstep;
            const char* a2 = last ? nA : cA + (size_t)(t + 2) * kstep; const char* b2 = last ? nB : cB + (size_t)(t + 2) * kstep;
            const char* a3 = a2 + kstep; const char* b3 = b2 + kstep;
            if (last && has_next) S.a_ready(nxt);
            if constexpr (SP2) {
            PG8_LDB(B0, 0, 0); PG8_LDB(B1, 0, 1); PG8_SCHED; PG8_LDA(At, 0, 0); PG8_STAGE(PG8_SA(1, 1), a1 + hstep, voffA);
            PG8_WAIT_V(8); PG8_WAIT_L(0); PG8_BAR; PG8_MMA(0, 0, At, B0); PG8_MMA(0, 1, At, B1); PG8_BAR; PG8_SCHED;
            PG8_LDA(At, 0, 1); PG8_STAGE(PG8_SB(0, 0), b2, voffB); PG8_STAGE(PG8_SB(0, 1), b2 + hstep, voffB); PG8_STAGE(PG8_SA(0, 0), a2, voffA);
            PG8_WAIT_V(8); PG8_WAIT_L(0); PG8_BAR; PG8_MMA(1, 0, At, B0); PG8_MMA(1, 1, At, B1); PG8_BAR; PG8_SCHED;
            PG8_LDB(B0, 1, 0); PG8_LDB(B1, 1, 1); PG8_SCHED; PG8_LDA(At, 1, 0); PG8_STAGE(PG8_SA(0, 1), a2 + hstep, voffA);
            PG8_WAIT_V(8); PG8_WAIT_L(0); PG8_BAR; PG8_MMA(0, 0, At, B0); PG8_MMA(0, 1, At, B1); PG8_BAR; PG8_SCHED;
            PG8_LDA(At, 1, 1); PG8_STAGE(PG8_SB(1, 0), b3, voffB); PG8_STAGE(PG8_SB(1, 1), b3 + hstep, voffB); PG8_STAGE(PG8_SA(1, 0), a3, voffA);
            PG8_WAIT_V(8); PG8_WAIT_L(0); PG8_BAR; PG8_MMA(1, 0, At, B0); PG8_MMA(1, 1, At, B1); PG8_BAR; PG8_SCHED;
            } else {
            PG8_LDB(B0, 0, 0); PG8_SCHED; PG8_LDA(At, 0, 0); PG8_STAGE(PG8_SA(1, 1), a1 + hstep, voffA);
            PG8_WAIT_L(8); PG8_BAR; PG8_WAIT_L(0); PG8_MMA(0, 0, At, B0); PG8_BAR; PG8_SCHED;
            PG8_LDB(B1, 0, 1); PG8_STAGE(PG8_SB(0, 0), b2, voffB);
            PG8_BAR; PG8_WAIT_L(0); PG8_MMA(0, 1, At, B1); PG8_BAR;
            PG8_LDA(At, 0, 1); PG8_STAGE(PG8_SA(0, 0), a2, voffA);
            PG8_BAR; PG8_WAIT_L(0); PG8_MMA(1, 0, At, B0); PG8_BAR; PG8_SCHED;
            PG8_STAGE(PG8_SB(0, 1), b2 + hstep, voffB);
            PG8_WAIT_V(6); PG8_BAR; PG8_MMA(1, 1, At, B1); PG8_BAR;
            PG8_LDB(B0, 1, 0); PG8_SCHED; PG8_LDA(At, 1, 0); PG8_STAGE(PG8_SA(0, 1), a2 + hstep, voffA);
            PG8_WAIT_L(8); PG8_BAR; PG8_WAIT_L(0); PG8_MMA(0, 0, At, B0); PG8_BAR; PG8_SCHED;
            PG8_LDB(B1, 1, 1); PG8_STAGE(PG8_SB(1, 0), b3, voffB);
            PG8_BAR; PG8_WAIT_L(0); PG8_MMA(0, 1, At, B1); PG8_BAR;
            PG8_LDA(At, 1, 1); PG8_STAGE(PG8_SA(1, 0), a3, voffA);
            PG8_BAR; PG8_WAIT_L(0); PG8_MMA(1, 0, At, B0); PG8_BAR; PG8_SCHED;
            PG8_STAGE(PG8_SB(1, 1), b3 + hstep, voffB);
            PG8_WAIT_V(6); PG8_BAR; PG8_MMA(1, 1, At, B1); PG8_BAR;
            }
        }
        if constexpr (ALIGN_EPI) { if (wr == 0) PG8_BAR; }
        if constexpr (!Epi::AFTER_DRAIN) { E(acc, cur, wr, wc, fr, fq); S.done(cur); }
        if (!has_next) break;
#pragma unroll
        for (int a = 0; a < 2; ++a)
#pragma unroll
            for (int b = 0; b < 2; ++b)
#pragma unroll
                for (int m = 0; m < 4; ++m)
#pragma unroll
                    for (int n = 0; n < 2; ++n) acc[a][b][m][n] = (f32x4){0.f, 0.f, 0.f, 0.f};
        cur = nxt; cA = nA; cB = nB; ++ui;
        if constexpr (ALIGN_EPI) { if (wr == 1) PG8_BAR; }
    }
    PG8_WAIT_V(0);
    if constexpr (!ALIGN_EPI) { if (wr == 0) PG8_BAR; }
    PG8_BAR;
    if constexpr (Epi::AFTER_DRAIN) { E.fused(acc, cur, wr, wc, fr, fq, lds, wid, lane); S.done(cur); }
#undef PG8_SA
#undef PG8_SB
#undef PG8_STAGE
#undef PG8_LDA
#undef PG8_LDB
#undef PG8_MMA
#undef PG8_WAIT_V
#undef PG8_WAIT_L
#undef PG8_BAR
#undef PG8_SCHED
}

__device__ __forceinline__ float bf_lo(unsigned w) { return __builtin_bit_cast(float, w << 16); }
__device__ __forceinline__ float bf_hi(unsigned w) { return __builtin_bit_cast(float, w & 0xffff0000u); }
__device__ __forceinline__ float sigmoid_f(float x) { return __builtin_amdgcn_rcpf(1.0f + __builtin_amdgcn_exp2f(-1.4426950408889634f * x)); }
__device__ __forceinline__ float gelu_tanh_f(float x) { const float u = x * (1.0f + 0.044715f * x * x); return x * __builtin_amdgcn_rcpf(1.0f + __builtin_amdgcn_exp2f(-2.3022081981f * u)); }
__device__ __forceinline__ u32x4 pack8(f32x4 a, f32x4 b) { u32x4 w; w.x = cvt_pk_bf16(a[0], a[1]); w.y = cvt_pk_bf16(a[2], a[3]); w.z = cvt_pk_bf16(b[0], b[1]); w.w = cvt_pk_bf16(b[2], b[3]); return w; }

struct EpiIn {
    static constexpr bool PERM = true, AFTER_DRAIN = false;
    bf16_t* reg5; bf16_t* reg2; size_t rstride; float qscale; unsigned* kn2;
    __device__ __forceinline__ void operator()(const f32x4 (&acc)[2][2][4][2], const Unit& u, int wr, int wc, int fr, int fq) const {
        const int region = u.pn >> 2, colt = (u.pn & 3) * BM;
        bf16_t* base = (region < 5) ? reg5 + (size_t)region * rstride : reg2 + (size_t)(region - 5) * rstride;
        const int row0 = u.pm * BM + wr * 64 + fr, col0 = colt + wc * 32 + 8 * fq;
        const int mode = (region < 3) ? 0 : (region < 5 ? 1 : 2);
        const float sc = (region == 0) ? qscale : 1.0f;
#pragma unroll
        for (int ai = 0; ai < 2; ++ai)
#pragma unroll
            for (int m = 0; m < 4; ++m) { bf16_t* rowp = base + (size_t)(row0 + ai * HALF + m * 16) * 1024 + col0;
#pragma unroll
                for (int bj = 0; bj < 2; ++bj) { f32x4 v0 = acc[ai][bj][m][0], v1 = acc[ai][bj][m][1];
                    if (mode == 0) { v0 = v0 * sc; v1 = v1 * sc; }
                    else if (mode == 1) {
#pragma unroll
                        for (int e = 0; e < 4; ++e) { v0[e] = gelu_tanh_f(v0[e]); v1[e] = gelu_tanh_f(v1[e]); } }
                    else {
#pragma unroll
                        for (int e = 0; e < 4; ++e) { v0[e] = sigmoid_f(v0[e]); v1[e] = sigmoid_f(v1[e]); } }
                    *(u32x4*)(rowp + bj * HALF) = pack8(v0, v1); } }
        if (region == 1) {
            const int b = (u.pm * BM) >> 11, wvl = (int)(threadIdx.x & 63);
#pragma unroll
            for (int ai = 0; ai < 2; ++ai)
#pragma unroll
                for (int bj = 0; bj < 2; ++bj) { float mx = 0.f;
#pragma unroll
                    for (int m = 0; m < 4; ++m) { const u32x4 w = pack8(acc[ai][bj][m][0], acc[ai][bj][m][1]);
                        float sq = bf_lo(w.x) * bf_lo(w.x) + bf_hi(w.x) * bf_hi(w.x) + bf_lo(w.y) * bf_lo(w.y) + bf_hi(w.y) * bf_hi(w.y) + bf_lo(w.z) * bf_lo(w.z) + bf_hi(w.z) * bf_hi(w.z) + bf_lo(w.w) * bf_lo(w.w) + bf_hi(w.w) * bf_hi(w.w);
                        sq += __shfl_xor(sq, 16); sq += __shfl_xor(sq, 32); mx = __builtin_fmaxf(mx, sq); }
                    mx = __builtin_fmaxf(mx, __shfl_xor(mx, 1)); mx = __builtin_fmaxf(mx, __shfl_xor(mx, 2)); mx = __builtin_fmaxf(mx, __shfl_xor(mx, 4)); mx = __builtin_fmaxf(mx, __shfl_xor(mx, 8));
                    const int hm = 4 * (u.pn & 3) + 2 * bj + (wc >> 1), tl = (((u.pm * BM) & 2047) >> 6) + 2 * ai + wr;
                    if (wvl == 0) atomicMax(kn2 + (((wc & 1) * 16 + b) * 16 + hm) * 32 + tl, __builtin_bit_cast(unsigned, mx)); }
        }
    }
};

template <bool FIRST> struct EpiGate {
    static constexpr bool PERM = true, AFTER_DRAIN = false;
    const bf16_t* G; bf16_t* Y;
    __device__ __forceinline__ void operator()(const f32x4 (&acc)[2][2][4][2], const Unit& u, int wr, int wc, int fr, int fq) const {
        const int row0 = u.pm * BM + wr * 64 + fr, col0 = u.pn * BM + wc * 32 + 8 * fq;
#pragma unroll
        for (int ai = 0; ai < 2; ++ai)
#pragma unroll
            for (int m = 0; m < 4; ++m) { const size_t ro = (size_t)(row0 + ai * HALF + m * 16) * 1024 + col0;
#pragma unroll
                for (int bj = 0; bj < 2; ++bj) { const u32x4 g = *(const u32x4*)(G + ro + bj * HALF);
                    f32x4 v0 = acc[ai][bj][m][0], v1 = acc[ai][bj][m][1];
                    v0[0] *= bf_lo(g.x); v0[1] *= bf_hi(g.x); v0[2] *= bf_lo(g.y); v0[3] *= bf_hi(g.y);
                    v1[0] *= bf_lo(g.z); v1[1] *= bf_hi(g.z); v1[2] *= bf_lo(g.w); v1[3] *= bf_hi(g.w);
                    if (!FIRST) { const u32x4 y = *(const u32x4*)(Y + ro + bj * HALF);
                        v0[0] += bf_lo(y.x); v0[1] += bf_hi(y.x); v0[2] += bf_lo(y.y); v0[3] += bf_hi(y.y);
                        v1[0] += bf_lo(y.z); v1[1] += bf_hi(y.z); v1[2] += bf_lo(y.w); v1[3] += bf_hi(y.w); }
                    *(u32x4*)(Y + ro + bj * HALF) = pack8(v0, v1); } }
    }
};

struct EpiRes {
    static constexpr bool PERM = true, AFTER_DRAIN = false;
    const float* X; float* O; const float* gate; int modld; int rpb;
    __device__ __forceinline__ void operator()(const f32x4 (&acc)[2][2][4][2], const Unit& u, int wr, int wc, int fr, int fq) const {
        const int row0 = u.pm * BM + wr * 64 + fr, col0 = u.pn * BM + wc * 32 + 8 * fq;
        const float* gp = gate + (size_t)((u.pm * BM) / rpb) * modld + col0;
        f32x4 gv[2][2];
#pragma unroll
        for (int bj = 0; bj < 2; ++bj)
#pragma unroll
            for (int n = 0; n < 2; ++n) gv[bj][n] = *(const f32x4*)(gp + bj * HALF + 4 * n);
#pragma unroll
        for (int ai = 0; ai < 2; ++ai)
#pragma unroll
            for (int m = 0; m < 4; ++m) { const size_t ro = (size_t)(row0 + ai * HALF + m * 16) * 1024 + col0;
#pragma unroll
                for (int bj = 0; bj < 2; ++bj)
#pragma unroll
                    for (int n = 0; n < 2; ++n) { const f32x4 xv = *(const f32x4*)(X + ro + bj * HALF + 4 * n);
                        *(f32x4*)(O + ro + bj * HALF + 4 * n) = xv + gv[bj][n] * acc[ai][bj][m][n]; } }
    }
};

struct EpiGU {
    static constexpr bool PERM = true, AFTER_DRAIN = false;
    bf16_t* ACT;
    __device__ __forceinline__ void operator()(const f32x4 (&acc)[2][2][4][2], const Unit& u, int wr, int wc, int fr, int fq) const {
        const int row0 = u.pm * BM + wr * 64 + fr, col0 = (u.pn & 1) * HALF + wc * 32 + 8 * fq;
#pragma unroll
        for (int ai = 0; ai < 2; ++ai)
#pragma unroll
            for (int m = 0; m < 4; ++m) { f32x4 v[2];
#pragma unroll
                for (int n = 0; n < 2; ++n)
#pragma unroll
                    for (int e = 0; e < 4; ++e) { const float g = acc[ai][0][m][n][e]; v[n][e] = g * sigmoid_f(g) * acc[ai][1][m][n][e]; }
                *(u32x4*)(ACT + (size_t)(row0 + ai * HALF + m * 16) * 256 + col0) = pack8(v[0], v[1]); }
    }
};

struct EpiDown {
    static constexpr bool PERM = true, AFTER_DRAIN = false;
    bf16_t* EO;
    __device__ __forceinline__ void operator()(const f32x4 (&acc)[2][2][4][2], const Unit& u, int wr, int wc, int fr, int fq) const {
        const int row0 = u.pm * BM + wr * 64 + fr, col0 = (u.pn & 3) * BM + wc * 32 + 8 * fq;
#pragma unroll
        for (int ai = 0; ai < 2; ++ai)
#pragma unroll
            for (int m = 0; m < 4; ++m) { bf16_t* rowp = EO + (size_t)(row0 + ai * HALF + m * 16) * 1024 + col0;
#pragma unroll
                for (int bj = 0; bj < 2; ++bj) *(u32x4*)(rowp + bj * HALF) = pack8(acc[ai][bj][m][0], acc[ai][bj][m][1]); }
    }
};

template <int NPN> struct MoeOrder {
    const volatile PG8_LAS int* tbl; int ntiles, G, c;
    __device__ __forceinline__ bool next(int i, Unit& u) const {
        const int L = i * G + c; if (L >= ntiles * NPN) return false;
        u.pm = L / NPN; u.pn = __builtin_amdgcn_readfirstlane(tbl[u.pm]) * NPN + (L % NPN); return true;
    }
    __device__ __forceinline__ void a_ready(const Unit&) const {}
    __device__ __forceinline__ void done(const Unit&) const {}
};
}

namespace att {
typedef unsigned short bf16;
using bf16x8 = __attribute__((ext_vector_type(8))) short;
using s16x4 = __attribute__((ext_vector_type(4))) short;
using f32x16 = __attribute__((ext_vector_type(16))) float;
using u32x4 = __attribute__((ext_vector_type(4))) unsigned;
typedef float f32x4 __attribute__((ext_vector_type(4)));
typedef short v4i16_t __attribute__((ext_vector_type(4)));
typedef __attribute__((address_space(3))) const char* lds_cptr;
constexpr int SEQ = 2048, DM = 1024, KVB = 64, NT = SEQ / KVB, QROWS = 128;
constexpr int SLOT = 16384, L_K = 0, L_V = 3 * SLOT, L_WS = 6 * SLOT, L_X = 0, ATT_LDS = L_WS + 8 * 64 * 4;
constexpr float THR = 8.0f, SKIPC = 40.0f;
__device__ __forceinline__ int crow(int r, int hi) { return (r & 3) + 8 * (r >> 2) + 4 * hi; }
__device__ __forceinline__ void glds16(const void* gsrc, unsigned lds_dst) { unsigned keep;
    asm volatile("s_mov_b32 %0, m0\n\ts_mov_b32 m0, %2\n\ts_nop 0\n\tglobal_load_lds_dwordx4 %1, off\n\ts_mov_b32 m0, %0" : "=&s"(keep) : "v"(gsrc), "s"(lds_dst) : "memory"); }
typedef float f32x2_t __attribute__((ext_vector_type(2))); typedef __bf16 bf16x2_t __attribute__((ext_vector_type(2)));
__device__ __forceinline__ unsigned cvtpk(float lo, float hi) { f32x2_t v = {lo, hi}; bf16x2_t b = __builtin_convertvector(v, bf16x2_t); return __builtin_bit_cast(unsigned, b); }
__device__ __forceinline__ s16x4 vtr(lds_cptr p) { return __builtin_bit_cast(s16x4, __builtin_amdgcn_ds_read_tr16_b64_v4i16((__attribute__((address_space(3))) v4i16_t*)p)); }
#define ATT_WAIT_BAR(N) asm volatile("s_waitcnt vmcnt(" #N ") lgkmcnt(0)\n\ts_barrier" ::: "memory")

#ifndef ATT_ECHO
#define ATT_ECHO 0
#endif
#ifndef ATT_ECHO_WAVE
#define ATT_ECHO_WAVE 0
#endif
#define ECHO_B(id) do { if (ATT_ECHO == (id) && echo_on) { t0_ = __builtin_amdgcn_s_memtime(); } } while (0)
#define ECHO_E(id) do { if (ATT_ECHO == (id) && echo_on) { const unsigned d_ = (unsigned)__builtin_amdgcn_readfirstlane((int)(__builtin_amdgcn_s_memtime() - t0_)); if ((threadIdx.x & 63) == 0) *tacc += d_; } } while (0)
__device__ __forceinline__ void attn_unit(int b, int h, int qb, const bf16* Q, const bf16* __restrict__ K, const bf16* __restrict__ V, bf16* O, char* shm, float lam, float slope2, const float* __restrict__ subg, float oscale, volatile __attribute__((address_space(3))) unsigned* tacc, const unsigned* __restrict__ kn2) {
    unsigned long long t0_ = 0; const bool echo_on = (ATT_ECHO != 0) && blockIdx.x == 0 && __builtin_amdgcn_readfirstlane(threadIdx.x >> 6) == ATT_ECHO_WAVE;
    const int tid = threadIdx.x, lane = tid & 63, r32 = lane & 31, hi = lane >> 5;
    const int wid = __builtin_amdgcn_readfirstlane(tid >> 6), mp = wid >> 2, wq = wid & 3;
    const long rowbase = (long)b * SEQ; const int q0 = qb * QROWS;
    const bf16* Qw = Q + (rowbase + q0 + wq * 32) * DM + h * 128 + mp * 64;
    const bf16* Kh = K + rowbase * DM + h * 128; const bf16* Vh = V + rowbase * DM + h * 128;
    const unsigned lds0 = (unsigned)(uintptr_t)shm;
    volatile __attribute__((address_space(3))) float* wsf = (volatile __attribute__((address_space(3))) float*)((__attribute__((address_space(3))) char*)shm + L_WS) + wid * 64;
    const int rr_ = lane >> 4, pp_ = lane & 15;
    const bf16* ksrcA = Kh + (long)(8 * wid + rr_) * DM + (pp_ ^ ((8 * wid + rr_) & 15)) * 8;
    const bf16* ksrcB = Kh + (long)(8 * wid + 4 + rr_) * DM + (pp_ ^ ((8 * wid + 4 + rr_) & 15)) * 8;
    const bf16* vsrcA = Vh + (long)(8 * wid + rr_) * DM + (pp_ ^ (rr_ << 2)) * 8;
    const unsigned kdst = lds0 + L_K + (2 * wid) * 1024, vdst = lds0 + L_V + (2 * wid) * 1024;
#define ATT_DMA_STAGE(s, kso, vso) do { const int kt_ = t_lo + ((s) < NTu ? (s) : NTu - 1), vt_ = t_lo + ((s) < 1 ? 0 : ((s) - 1 < NTu ? (s) - 1 : NTu - 1)); \
        const long gk_ = (long)kt_ * KVB * DM, gv_ = (long)vt_ * KVB * DM; const unsigned ko_ = (unsigned)(kso), vo_ = (unsigned)(vso); \
        glds16(ksrcA + gk_, (unsigned)__builtin_amdgcn_readfirstlane(kdst + ko_)); glds16(ksrcB + gk_, (unsigned)__builtin_amdgcn_readfirstlane(kdst + ko_ + 1024)); \
        glds16(vsrcA + gv_, (unsigned)__builtin_amdgcn_readfirstlane(vdst + vo_)); glds16(vsrcA + gv_ + 4 * DM, (unsigned)__builtin_amdgcn_readfirstlane(vdst + vo_ + 1024)); \
        if (ATT_DMA_DOUBLE) { glds16(ksrcA + gk_, (unsigned)__builtin_amdgcn_readfirstlane(kdst + ko_)); glds16(ksrcB + gk_, (unsigned)__builtin_amdgcn_readfirstlane(kdst + ko_ + 1024)); \
        glds16(vsrcA + gv_, (unsigned)__builtin_amdgcn_readfirstlane(vdst + vo_)); glds16(vsrcA + gv_ + 4 * DM, (unsigned)__builtin_amdgcn_readfirstlane(vdst + vo_ + 1024)); } } while (0)
    bf16x8 qr[4];
#pragma unroll
    for (int d0 = 0; d0 < 4; ++d0) qr[d0] = *reinterpret_cast<const bf16x8*>(&Qw[(long)r32 * DM + d0 * 16 + hi * 8]);
    asm volatile("" : "+v"(qr[0]), "+v"(qr[1]), "+v"(qr[2]), "+v"(qr[3]));
    int t_lo = 0, NTu = NT;
    { float qs = 0.f;
#pragma unroll
      for (int d0 = 0; d0 < 4; ++d0) { const u32x4 w = __builtin_bit_cast(u32x4, qr[d0]);
          qs += pg8::bf_lo(w.x) * pg8::bf_lo(w.x) + pg8::bf_hi(w.x) * pg8::bf_hi(w.x) + pg8::bf_lo(w.y) * pg8::bf_lo(w.y) + pg8::bf_hi(w.y) * pg8::bf_hi(w.y)
              + pg8::bf_lo(w.z) * pg8::bf_lo(w.z) + pg8::bf_hi(w.z) * pg8::bf_hi(w.z) + pg8::bf_lo(w.w) * pg8::bf_lo(w.w) + pg8::bf_hi(w.w) * pg8::bf_hi(w.w); }
      qs += __shfl_xor(qs, 32);
#pragma unroll
      for (int off = 1; off < 32; off <<= 1) qs = __builtin_fmaxf(qs, __shfl_xor(qs, off));
      float ks = __builtin_bit_cast(float, kn2[(((lane >> 5) * 16 + b) * 16 + 2 * h + mp) * 32 + (lane & 31)]);
      ks += __shfl_xor(ks, 32);
#pragma unroll
      for (int off = 1; off < 32; off <<= 1) ks = __builtin_fmaxf(ks, __shfl_xor(ks, off));
      const float bnd = 2.0f * __builtin_sqrtf(qs * ks) * 1.0001f + SKIPC;
      if (lane == 0) wsf[0] = bnd;
      asm volatile("s_waitcnt lgkmcnt(0)\n\ts_barrier" ::: "memory");
      volatile __attribute__((address_space(3))) float* wsa = (volatile __attribute__((address_space(3))) float*)((__attribute__((address_space(3))) char*)shm + L_WS);
      float bmax = wsa[0];
#pragma unroll
      for (int w = 1; w < 8; ++w) bmax = __builtin_fmaxf(bmax, wsa[64 * w]);
      const float dskip = bmax / slope2;
      const int lo_key = (int)__builtin_fmaxf((float)q0 - dskip, 0.f), hi_key = (int)__builtin_fminf((float)(q0 + 127) + dskip, (float)(SEQ - 1));
      t_lo = __builtin_amdgcn_readfirstlane(lo_key >> 6); const int t_hi = __builtin_amdgcn_readfirstlane(hi_key >> 6); NTu = t_hi - t_lo + 1; }
    const lds_cptr shm3 = (lds_cptr)shm;
    lds_cptr kpd[4], vpd[4];
    { const int qq = (lane & 15) >> 2;
#pragma unroll
      for (int i = 0; i < 4; ++i) { kpd[i] = shm3 + L_K + r32 * 256 + (((8 * mp + 2 * i + hi) ^ (r32 & 15)) * 16);
          vpd[i] = shm3 + L_V + (4 * hi + qq) * 256 + ((i ^ qq) * 64) + ((lane >> 4) & 1) * 32 + (lane & 3) * 8; } }
    const int qpos = q0 + wq * 32 + r32;
    float mhat = -1e30f, lsum = 0.f;
    f32x16 o[4];
#pragma unroll
    for (int i = 0; i < 4; ++i) o[i] = f32x16{};
    f32x16 p0 = f32x16{}, p1 = f32x16{};
    u32x4 pw0 = {0u, 0u, 0u, 0u}, pw1 = pw0, pw2 = pw0, pw3 = pw0;
    int s_prev = 2 * SLOT, s_cur = 0, s_next = SLOT;
#ifndef ATT_DMA_DOUBLE
#define ATT_DMA_DOUBLE 0
#endif
#define ATT_WAIT_STAGE() do { if (ATT_DMA_DOUBLE) { ATT_WAIT_BAR(8); } else { ATT_WAIT_BAR(4); } } while (0)
#ifndef ATT_SETPRIO
#define ATT_SETPRIO 0
#endif
#ifndef ATT_PROBE
#define ATT_PROBE 0
#endif
#ifndef ATT_REP_MAIN
#define ATT_REP_MAIN 1
#endif
#ifndef ATT_REP_EPI
#define ATT_REP_EPI 1
#endif
#define ATT_ROT() do { const int o_ = s_prev; s_prev = s_cur; s_cur = s_next; s_next = o_; } while (0)
#define ATT_SB() __builtin_amdgcn_sched_barrier(0)
#define ATT_VLD(dst, vo_, ks) do { _Pragma("unroll") for (int db_ = 0; db_ < 4; ++db_) { dst[db_][0] = vtr(vpd[db_] + (vo_) + (ks) * 4096); dst[db_][1] = vtr(vpd[db_] + (vo_) + (ks) * 4096 + 2048); } } while (0)
#define ATT_VF(src, db_) (bf16x8){src[db_][0][0], src[db_][0][1], src[db_][0][2], src[db_][0][3], src[db_][1][0], src[db_][1][1], src[db_][1][2], src[db_][1][3]}
#define ATT_PV4(pw_, src) do { _Pragma("unroll") for (int db_ = 0; db_ < 4; ++db_) o[db_] = __builtin_amdgcn_mfma_f32_32x32x16_bf16(__builtin_bit_cast(bf16x8, pw_), ATT_VF(src, db_), o[db_], 0, 0, 0); } while (0)
#define ATT_KLD(dst, ko_, d0) do { dst[0] = *(const __attribute__((address_space(3))) bf16x8*)(kpd[d0] + (ko_)); dst[1] = *(const __attribute__((address_space(3))) bf16x8*)(kpd[d0] + (ko_) + 8192); } while (0)
#define ATT_FRD(i_) do { if ((i_) < 16) { if (DO_PV_) { const int ks_ = (i_) >> 2, db_ = (i_) & 3; vf_[(i_) % 5][0] = vtr(vpd[db_] + vp_ + ks_ * 4096); vf_[(i_) % 5][1] = vtr(vpd[db_] + vp_ + ks_ * 4096 + 2048); } } \
        else if ((i_) < 24) { if (DO_QK_) { const int d0_ = ((i_) - 16) >> 1, hf_ = ((i_) - 16) & 1; kf_[(i_) % 5] = *(const __attribute__((address_space(3))) bf16x8*)(kpd[d0_] + kp_ + hf_ * 8192); } } } while (0)
#define ATT_FMA(i_) do { if ((i_) < 16) { if (DO_PV_) { const int ks_ = (i_) >> 2, db_ = (i_) & 3; const u32x4 pw_ = (ks_ == 0) ? pw0 : (ks_ == 1) ? pw1 : (ks_ == 2) ? pw2 : pw3; \
            const bf16x8 vv_ = (bf16x8){vf_[(i_) % 5][0][0], vf_[(i_) % 5][0][1], vf_[(i_) % 5][0][2], vf_[(i_) % 5][0][3], vf_[(i_) % 5][1][0], vf_[(i_) % 5][1][1], vf_[(i_) % 5][1][2], vf_[(i_) % 5][1][3]}; \
            o[db_] = __builtin_amdgcn_mfma_f32_32x32x16_bf16(__builtin_bit_cast(bf16x8, pw_), vv_, o[db_], 0, 0, 0); } } \
        else { if (DO_QK_) { const int d0_ = ((i_) - 16) >> 1, hf_ = ((i_) - 16) & 1; \
            if (hf_ == 0) p0 = __builtin_amdgcn_mfma_f32_32x32x16_bf16(kf_[(i_) % 5], qr[d0_], d0_ == 0 ? f32x16{} : p0, 0, 0, 0); else p1 = __builtin_amdgcn_mfma_f32_32x32x16_bf16(kf_[(i_) % 5], qr[d0_], d0_ == 0 ? f32x16{} : p1, 0, 0, 0); } } } while (0)
#define ATT_MPHASE(DO_PV, DO_QK) do { \
        constexpr bool DO_PV_ = (DO_PV), DO_QK_ = (DO_QK); \
        const int vp_ = s_prev, kp_ = s_cur; \
        s16x4 vf_[5][2]; bf16x8 kf_[5]; \
        constexpr int I0_ = DO_PV_ ? 0 : 16, I1_ = DO_QK_ ? 24 : 16; \
        _Pragma("unroll") for (int i_ = I0_; i_ < I0_ + 4; ++i_) ATT_FRD(i_); \
        ATT_SB(); \
        _Pragma("unroll") for (int i_ = I0_; i_ < I1_; ++i_) { if (i_ + 4 < I1_) ATT_FRD(i_ + 4); ATT_SB(); ATT_FMA(i_); ATT_SB(); } \
    } while (0)
#define ATT_SPHASE(tt) do { \
        const float dq = (float)((tt) * KVB + 4 * hi - qpos); \
        _Pragma("unroll") for (int r = 0; r < 16; ++r) { const float c = (float)((r & 3) + 8 * (r >> 2)); \
            p0[r] = __builtin_fmaf(-slope2, __builtin_fabsf(dq + c), p0[r]); p1[r] = __builtin_fmaf(-slope2, __builtin_fabsf(dq + (c + 32.f)), p1[r]); } \
        float rm = __builtin_fmaxf(p0[0], p1[0]); \
        _Pragma("unroll") for (int r = 1; r < 16; ++r) rm = __builtin_fmaxf(rm, __builtin_fmaxf(p0[r], p1[r])); \
        { auto rr = __builtin_amdgcn_permlane32_swap(__float_as_uint(rm), __float_as_uint(rm), false, false); rm = __builtin_fmaxf(__uint_as_float(rr[0]), __uint_as_float(rr[1])); } \
        bool resc = false; \
        if (__any(rm > mhat + THR)) { const float mn = __builtin_fmaxf(mhat, rm); const float f = __builtin_amdgcn_exp2f(mhat - mn); mhat = mn; lsum *= f; if (hi == 0) wsf[r32] = f; resc = true; } \
        if (ATT_PROBE == 2) { float mh2 = mhat; asm volatile("" : "+v"(mh2)); _Pragma("unroll") for (int r = 0; r < 16; ++r) { float e0 = __builtin_amdgcn_exp2f(p0[r] - mh2), e1 = __builtin_amdgcn_exp2f(p1[r] - mh2); asm volatile("" :: "v"(e0), "v"(e1)); } } \
        float sacc = 0.f; \
        _Pragma("unroll") for (int r = 0; r < 16; ++r) { p0[r] = __builtin_amdgcn_exp2f(p0[r] - mhat); p1[r] = __builtin_amdgcn_exp2f(p1[r] - mhat); sacc += p0[r] + p1[r]; } \
        lsum += sacc; \
        pw0 = (u32x4){cvtpk(p0[0], p0[1]), cvtpk(p0[2], p0[3]), cvtpk(p0[4], p0[5]), cvtpk(p0[6], p0[7])}; \
        pw1 = (u32x4){cvtpk(p0[8], p0[9]), cvtpk(p0[10], p0[11]), cvtpk(p0[12], p0[13]), cvtpk(p0[14], p0[15])}; \
        pw2 = (u32x4){cvtpk(p1[0], p1[1]), cvtpk(p1[2], p1[3]), cvtpk(p1[4], p1[5]), cvtpk(p1[6], p1[7])}; \
        pw3 = (u32x4){cvtpk(p1[8], p1[9]), cvtpk(p1[10], p1[11]), cvtpk(p1[12], p1[13]), cvtpk(p1[14], p1[15])}; \
        if (resc) { asm volatile("s_waitcnt lgkmcnt(0)" ::: "memory"); \
            _Pragma("unroll") for (int r = 0; r < 16; ++r) { const float f = wsf[crow(r, hi)]; _Pragma("unroll") for (int db = 0; db < 4; ++db) o[db][r] *= f; } } \
    } while (0)
#define ATT_BAR1() asm volatile("s_waitcnt lgkmcnt(0)\n\ts_barrier" ::: "memory")
#define ATT_BAR() do { ATT_BAR1(); if (ATT_PROBE == 3) { ATT_BAR1(); ATT_BAR1(); } } while (0)
    for (int rep_ = 0; rep_ < ATT_REP_MAIN; ++rep_) {
    if (rep_ > 0) { ATT_WAIT_BAR(0); mhat = -1e30f; lsum = 0.f; s_prev = 2 * SLOT; s_cur = 0; s_next = SLOT;
#pragma unroll
        for (int i = 0; i < 4; ++i) o[i] = f32x16{}; }
    ATT_DMA_STAGE(0, 0, 2 * SLOT); ATT_DMA_STAGE(1, SLOT, 0);
    if (mp == 0) {
        ATT_WAIT_STAGE(); ATT_DMA_STAGE(2, s_prev, s_next); ATT_MPHASE(false, true); ATT_BAR(); ATT_SPHASE(t_lo); ATT_ROT();
        ECHO_B(6);
        for (int t = 1; t < NTu; ++t) { ECHO_B(3); ATT_WAIT_STAGE(); ECHO_E(3); ECHO_B(5); ATT_DMA_STAGE(t + 2, s_prev, s_next); ECHO_E(5); ECHO_B(1); ATT_MPHASE(true, true); ECHO_E(1); ECHO_B(4); ATT_BAR(); ECHO_E(4); ECHO_B(2); ATT_SPHASE(t_lo + t); ECHO_E(2); ATT_ROT(); }
        ECHO_E(6);
        ATT_WAIT_STAGE(); ATT_MPHASE(true, false); ATT_BAR();
    } else {
        ATT_WAIT_STAGE(); ATT_DMA_STAGE(2, s_prev, s_next); ATT_BAR(); ATT_MPHASE(false, true); ATT_ROT();
        for (int t = 1; t < NTu; ++t) { ECHO_B(3); ATT_WAIT_STAGE(); ECHO_E(3); ECHO_B(5); ATT_DMA_STAGE(t + 2, s_prev, s_next); ECHO_E(5); ECHO_B(2); ATT_SPHASE(t_lo + t - 1); ECHO_E(2); ECHO_B(4); ATT_BAR(); ECHO_E(4); ECHO_B(1); ATT_MPHASE(true, true); ECHO_E(1); ATT_ROT(); }
        ATT_WAIT_STAGE(); ATT_SPHASE(t_lo + NTu - 1); ATT_BAR(); ATT_MPHASE(true, false);
    }
    }
#undef ATT_DMA_STAGE
#undef ATT_ROT
#undef ATT_SB
#undef ATT_VLD
#undef ATT_VF
#undef ATT_PV4
#undef ATT_KLD
#undef ATT_MPHASE
#undef ATT_FRD
#undef ATT_FMA
#undef ATT_SPHASE
#undef ATT_BAR
#undef ATT_BAR1
    { auto rr = __builtin_amdgcn_permlane32_swap(__float_as_uint(lsum), __float_as_uint(lsum), false, false); lsum = __uint_as_float(rr[0]) + __uint_as_float(rr[1]); }
    if (hi == 0) wsf[32 + r32] = lsum;
    asm volatile("s_waitcnt lgkmcnt(0)" ::: "memory");
    float rli[16];
#pragma unroll
    for (int r = 0; r < 16; ++r) rli[r] = __builtin_amdgcn_rcpf(wsf[32 + crow(r, hi)]);
    ATT_WAIT_BAR(0);
    __attribute__((address_space(3))) float* xch = (__attribute__((address_space(3))) float*)((__attribute__((address_space(3))) char*)shm + L_X) + wq * 4096 + lane;
    if (mp == 1) {
#pragma unroll
        for (int db = 0; db < 4; ++db)
#pragma unroll
            for (int r = 0; r < 16; ++r) xch[(db * 16 + r) * 64] = o[db][r] * (rli[r] * lam);
    }
    ATT_WAIT_BAR(0);
    if (mp == 0) {
        float ss[16];
#pragma unroll
        for (int r = 0; r < 16; ++r) ss[r] = 0.f;
#pragma unroll
        for (int db = 0; db < 4; ++db)
#pragma unroll
            for (int r = 0; r < 16; ++r) { const float v = o[db][r] * rli[r] - xch[(db * 16 + r) * 64]; o[db][r] = v; ss[r] += v * v; }
#pragma unroll
        for (int r = 0; r < 16; ++r) {
#pragma unroll
            for (int off = 1; off < 32; off <<= 1) ss[r] += __shfl_xor(ss[r], off);
            ss[r] = oscale * __builtin_amdgcn_rsqf(ss[r] * (1.0f / 128.0f) + 1e-6f); }
        bf16* Ow = O + (rowbase + q0 + wq * 32) * DM + h * 128 + r32;
        for (int rep_ = 0; rep_ < ATT_REP_EPI; ++rep_)
#pragma unroll
        for (int db = 0; db < 4; ++db) { const float g = subg[db * 32 + r32];
#pragma unroll
            for (int r = 0; r < 16; ++r) { const float v = o[db][r] * ss[r] * g; Ow[(long)crow(r, hi) * DM + db * 32] = (bf16)(cvtpk(v, v) & 0xffffu); } }
    }
    ATT_WAIT_BAR(0);
}

constexpr int SG_B = 0, SG_STAT = 32768, SG_LDS = SG_STAT + 128 * 8;
__device__ __forceinline__ void sgu_unit(int b, int n, const bf16* GS, bf16* GU, const bf16* __restrict__ Wsb, const float* __restrict__ bs, const float* __restrict__ lng, const float* __restrict__ lnb, char* shm) {
    const int tid = threadIdx.x, lane = tid & 63, r32 = lane & 31, hi = lane >> 5;
    const int wid = __builtin_amdgcn_readfirstlane(tid >> 6);
    const long row0 = (long)b * SEQ + n * 128;
    __attribute__((address_space(3))) float* stat = (__attribute__((address_space(3))) float*)((__attribute__((address_space(3))) char*)shm + SG_STAT);
    for (int i = 0; i < 16; ++i) { const int row = wid * 16 + i; const bf16* rp = GS + (row0 + row) * DM;
        const u32x4 a = *(const u32x4*)(rp + lane * 8), c = *(const u32x4*)(rp + 512 + lane * 8);
        float v[16];
        v[0] = pg8::bf_lo(a.x); v[1] = pg8::bf_hi(a.x); v[2] = pg8::bf_lo(a.y); v[3] = pg8::bf_hi(a.y); v[4] = pg8::bf_lo(a.z); v[5] = pg8::bf_hi(a.z); v[6] = pg8::bf_lo(a.w); v[7] = pg8::bf_hi(a.w);
        v[8] = pg8::bf_lo(c.x); v[9] = pg8::bf_hi(c.x); v[10] = pg8::bf_lo(c.y); v[11] = pg8::bf_hi(c.y); v[12] = pg8::bf_lo(c.z); v[13] = pg8::bf_hi(c.z); v[14] = pg8::bf_lo(c.w); v[15] = pg8::bf_hi(c.w);
        float s = 0.f;
#pragma unroll
        for (int k = 0; k < 16; ++k) s += v[k];
#pragma unroll
        for (int off = 1; off < 64; off <<= 1) s += __shfl_xor(s, off);
        const float mean = s * (1.0f / 1024.0f); float s2 = 0.f;
#pragma unroll
        for (int k = 0; k < 16; ++k) { const float d = v[k] - mean; s2 += d * d; }
#pragma unroll
        for (int off = 1; off < 64; off <<= 1) s2 += __shfl_xor(s2, off);
        if (lane == 0) { stat[2 * row] = mean; stat[2 * row + 1] = __builtin_amdgcn_rsqf(s2 * (1.0f / 1024.0f) + 1e-6f); }
    }
    __syncthreads();
    const int tb = wid >> 1, ch = wid & 1;
    for (int g = 0; g < 8; ++g) {
#pragma unroll
        for (int i = 0; i < 4; ++i) { const int idx = tid + 512 * i, s = idx >> 4, c0 = (idx & 15) * 8;
            const u32x4 a = *(const u32x4*)(GS + (row0 + s) * DM + g * 128 + c0);
            const float mean = stat[2 * s], rstd = stat[2 * s + 1];
            const f32x4 g0 = *(const f32x4*)(lng + g * 128 + c0), g1 = *(const f32x4*)(lng + g * 128 + c0 + 4), b0 = *(const f32x4*)(lnb + g * 128 + c0), b1 = *(const f32x4*)(lnb + g * 128 + c0 + 4);
            f32x4 x0 = {pg8::bf_lo(a.x), pg8::bf_hi(a.x), pg8::bf_lo(a.y), pg8::bf_hi(a.y)}, x1 = {pg8::bf_lo(a.z), pg8::bf_hi(a.z), pg8::bf_lo(a.w), pg8::bf_hi(a.w)};
            x0 = (x0 - mean) * rstd * g0 + b0; x1 = (x1 - mean) * rstd * g1 + b1;
            u32x4 w; w.x = cvtpk(x0[0], x0[1]); w.y = cvtpk(x0[2], x0[3]); w.z = cvtpk(x1[0], x1[1]); w.w = cvtpk(x1[2], x1[3]);
            *(__attribute__((address_space(3))) u32x4*)((__attribute__((address_space(3))) char*)shm + SG_B + (c0 >> 5) * 8192 + s * 64 + (c0 & 31) * 2) = w; }
        __syncthreads();
        f32x16 acc[2]; acc[0] = f32x16{}; acc[1] = f32x16{};
        const bf16* Ap = Wsb + ((long)g * 128 + tb * 32 + r32) * 128 + hi * 8;
        const lds_cptr bp = (lds_cptr)shm + SG_B + (2 * ch) * 8192 + ((lane >> 4) & 1) * 32 + (lane & 3) * 8 + (8 * hi + ((lane & 15) >> 2)) * 64;
#pragma unroll
        for (int ks = 0; ks < 8; ++ks) { const bf16x8 af = *(const bf16x8*)(Ap + ks * 16);
#pragma unroll
            for (int cb = 0; cb < 2; ++cb) { const s16x4 lo = vtr(bp + cb * 8192 + ks * 1024), hh = vtr(bp + cb * 8192 + ks * 1024 + 256);
                const bf16x8 vf = (bf16x8){lo[0], lo[1], lo[2], lo[3], hh[0], hh[1], hh[2], hh[3]};
                acc[cb] = __builtin_amdgcn_mfma_f32_32x32x16_bf16(af, vf, acc[cb], 0, 0, 0); } }
#pragma unroll
        for (int r = 0; r < 16; ++r) { const int t = tb * 32 + crow(r, hi); const float bias = bs[g * 128 + t];
            bf16* up = GU + (row0 + t) * DM + g * 128 + ch * 64 + r32;
#pragma unroll
            for (int cb = 0; cb < 2; ++cb) { const float uu = __builtin_bit_cast(float, (unsigned)up[cb * 32] << 16); const float v = uu * (acc[cb][r] + bias); up[cb * 32] = (bf16)(cvtpk(v, v) & 0xffffu); } }
        __syncthreads();
    }
}
#undef ATT_WAIT_BAR
}

constexpr int NWAVES = 8, NTHR = 512;
#ifndef MK_N_LAUNCHES
#define MK_N_LAUNCHES 1
#endif
constexpr int N_LAUNCHES = MK_N_LAUNCHES;
constexpr int N_PHASES = 11;

constexpr int BATCH = 16, SEQ = 2048, D = 1024, T = BATCH * SEQ, NIN = 7 * D, NEXP = 32, DEXP = 256;
constexpr int NRB = T / 128;
constexpr int MAXTILES = (2 * T + NEXP * 255) / 256 + 1;
constexpr float EPS = 1e-6f;
constexpr size_t MiB = 1u << 20, KiB = 1u << 10;
constexpr size_t WS_CTL = 0, CTL_ZERO_BYTES = 1 * MiB;
constexpr size_t WS_MOD = 1 * MiB, WS_CB = 1 * MiB + 512 * KiB, WS_WR = 2 * MiB;
constexpr size_t WS_TOKE = 5 * MiB, WS_TOKW0 = WS_TOKE + 128 * KiB, WS_TOKW1 = WS_TOKE + 256 * KiB, WS_TOKR = WS_TOKE + 384 * KiB, WS_SLOT0 = WS_TOKE + 512 * KiB, WS_SLOT1 = WS_TOKE + 640 * KiB;
constexpr size_t WS_HIST = 6 * MiB, WS_WSB = 6 * MiB + 512 * KiB;
constexpr size_t WS_WIN = 8 * MiB, WS_WAP = 22 * MiB, WS_WSP = 24 * MiB, WS_WOUT = 26 * MiB, WS_WGU = 28 * MiB, WS_WD = 60 * MiB;
constexpr size_t WS_H = 80 * MiB, WS_Q = 144 * MiB, WS_K = 208 * MiB, WS_V = 272 * MiB, WS_U = 336 * MiB, WS_S = 400 * MiB;
constexpr size_t WS_ATT = WS_H, WS_Y = WS_K, WS_H2S = 144 * MiB, WS_ACT = 296 * MiB, WS_EO = 336 * MiB, WS_END = 480 * MiB;
static_assert(WS_H2S + (size_t)MAXTILES * 256 * D * 2 <= WS_ACT && WS_ACT + (size_t)MAXTILES * 256 * DEXP * 2 <= WS_EO && WS_EO + (size_t)MAXTILES * 256 * D * 2 <= WS_END, "MoE buffers");
constexpr int CW_TMO = 0, CW_BAR = 4096;
constexpr size_t WS_KN2 = 512 * KiB;
constexpr int RING_OFF = 0, RING_BYTES = 131072, LDSCTL_OFF = RING_BYTES, MISC_OFF = LDSCTL_OFF + 320, LT_NT = LDSCTL_OFF + 1024, LT_TBL = LDSCTL_OFF + 1040, LT_EBASE = LT_TBL + 320 * 4, LT_BEF = LT_EBASE + 36 * 4;
constexpr int LDS_BYTES = 147456;
static_assert(LT_BEF + 32 * 4 <= LDS_BYTES && att::ATT_LDS <= RING_BYTES && att::SG_LDS <= RING_BYTES, "LDS map");

#define GAS __attribute__((address_space(1)))
#define LAS __attribute__((address_space(3)))
typedef unsigned short bf16;
typedef unsigned v4u __attribute__((ext_vector_type(4)));
typedef unsigned v2u __attribute__((ext_vector_type(2)));
typedef float f32x4 __attribute__((ext_vector_type(4)));
typedef GAS unsigned gu32;
#define RLX_AGENT __ATOMIC_RELAXED, __HIP_MEMORY_SCOPE_AGENT
#define LDS_WAIT() asm volatile("s_waitcnt lgkmcnt(0)" ::: "memory")
#define VM_WAIT() asm volatile("s_waitcnt vmcnt(0)" ::: "memory")
__device__ __forceinline__ unsigned f2bf(float f) { unsigned u = __builtin_bit_cast(unsigned, f); return (u + 0x7fffu + ((u >> 16) & 1u)) >> 16; }
__device__ __forceinline__ unsigned pk2(float lo, float hi) { return f2bf(lo) | (f2bf(hi) << 16); }
__device__ __forceinline__ float wave_sum(float v) {
#pragma unroll
    for (int o = 1; o < 64; o <<= 1) v += __shfl_xor(v, o);
    return v;
}

#define XB_TMO      128
#define XB_XCNT(j)  (256  + 64 * (j))
#define XB_XSUB(j)  (1280 + 64 * (j))
#define XB_XGEN(j)  (2304 + 64 * (j))
#define XB_TOP      3328
#define XB_TOPGEN   3392
#define XCD_BAR_WORDS 3456
#define XB_SPIN_CAP (1u << 18)

__device__ __forceinline__ unsigned xb_ld(unsigned* p)              { return __hip_atomic_load(p, __ATOMIC_RELAXED, __HIP_MEMORY_SCOPE_AGENT); }
__device__ __forceinline__ unsigned xb_add(unsigned* p, unsigned v) { return __hip_atomic_fetch_add(p, v, __ATOMIC_RELAXED, __HIP_MEMORY_SCOPE_AGENT); }
__device__ __forceinline__ unsigned xb_xcc_id() { return (unsigned)__builtin_amdgcn_s_getreg((3 << 11) | 20) & 0xFu; }
#define XB_SPIN(cond, bar) do { unsigned _sp = 0; while (cond) { __builtin_amdgcn_s_sleep(1); \
    if ((++_sp & 255u) == 0u) { if (xb_ld(&(bar)[XB_TMO])) break; if (_sp > XB_SPIN_CAP) { atomicAdd(&(bar)[XB_TMO], 1u); break; } } } } while (0)

struct XcdBarrier {
    unsigned* bar; unsigned x;
    volatile LAS unsigned* st;
};

__device__ __forceinline__ XcdBarrier xcd_barrier_post(unsigned* bar, volatile LAS unsigned* st) {
    XcdBarrier b; b.bar = bar; b.x = xb_xcc_id(); b.st = st;
    if (threadIdx.x == 0) (void)xb_add(&bar[XB_XCNT(b.x)], 1u);
    return b;
}
__device__ __forceinline__ void xcd_barrier_complete(unsigned* bar, unsigned x, unsigned& nloc, unsigned& nx) {
    const unsigned G = gridDim.x * gridDim.y * gridDim.z;
    unsigned sum, cnt, mine, sp = 0u;
    for (;;) {
        sum = 0u; cnt = 0u; mine = 0u;
#pragma unroll
        for (unsigned j = 0; j < 16; ++j) { const unsigned c = xb_ld(&bar[XB_XCNT(j)]); sum += c; cnt += (c > 0u) ? 1u : 0u; mine = (j == x) ? c : mine; }
        if (sum == G) break;
        __builtin_amdgcn_s_sleep(1);
        if ((++sp & 255u) == 0u) { if (xb_ld(&bar[XB_TMO])) break; if (sp > XB_SPIN_CAP) { atomicAdd(&bar[XB_TMO], 1u); break; } }
    }
    nloc = mine > 0u ? mine : 1u; nx = cnt > 0u ? cnt : 1u;
}

__device__ __forceinline__ void xcd_barrier(const XcdBarrier& b) {
    asm volatile("s_waitcnt vmcnt(0)" ::: "memory");
    __syncthreads();
    if (threadIdx.x == 0) {
        unsigned* bar = b.bar;
        __builtin_amdgcn_s_waitcnt(0);
        unsigned nloc = b.st[0], nx = b.st[1];
        if (nloc == 0u) { xcd_barrier_complete(bar, b.x, nloc, nx); b.st[0] = nloc; b.st[1] = nx; }
        const unsigned old = xb_add(&bar[XB_XSUB(b.x)], 1u);
        const unsigned gen = old / nloc;
        if (old + 1u == (gen + 1u) * nloc) {
            __builtin_amdgcn_fence(__ATOMIC_RELEASE, "agent");
            asm volatile("s_waitcnt vmcnt(0)" ::: "memory");
            const unsigned og = xb_add(&bar[XB_TOP], 1u);
            const unsigned tg = og / nx;
            if (og + 1u == (tg + 1u) * nx) xb_add(&bar[XB_TOPGEN], 1u);
            else XB_SPIN(xb_ld(&bar[XB_TOPGEN]) == tg, bar);
            __builtin_amdgcn_fence(__ATOMIC_ACQUIRE, "agent");
            xb_add(&bar[XB_XGEN(b.x)], 1u);
            asm volatile("s_waitcnt vmcnt(0)" ::: "memory");
        } else {
            XB_SPIN(xb_ld(&bar[XB_XGEN(b.x)]) == gen, bar);
            __builtin_amdgcn_fence(__ATOMIC_ACQUIRE, "agent");
            asm volatile("s_waitcnt vmcnt(0)" ::: "memory");
        }
    }
    __syncthreads();
}


__device__ __forceinline__ void tr_item(const float* W, int N, bf16* WT, int Kd, int k0, int n0, int drow0, int lane) {
    const int g = lane >> 4, c = lane & 15;
    const float* src = W + (size_t)(k0 + 16 * g) * N + n0 + 4 * c;
    f32x4 v[16];
#pragma unroll
    for (int i = 0; i < 16; ++i) v[i] = *(const f32x4*)(src + (size_t)i * N);
#pragma unroll
    for (int j = 0; j < 4; ++j) { bf16* dst = WT + (size_t)(drow0 + 4 * c + j) * Kd + k0 + 16 * g;
        v4u o0, o1;
        o0.x = pk2(v[0][j], v[1][j]); o0.y = pk2(v[2][j], v[3][j]); o0.z = pk2(v[4][j], v[5][j]); o0.w = pk2(v[6][j], v[7][j]);
        o1.x = pk2(v[8][j], v[9][j]); o1.y = pk2(v[10][j], v[11][j]); o1.z = pk2(v[12][j], v[13][j]); o1.w = pk2(v[14][j], v[15][j]);
        *(v4u*)dst = o0; *(v4u*)(dst + 8) = o1; }
}

struct Args { const float* in[26]; float* out; unsigned char* ws; int ph_lo, ph_hi, li, pad; };

__device__ __forceinline__ void p0_body(const Args& A, LAS unsigned char* lds, int tid, int lane, int wave, int bx, int G) {
    unsigned char* ws = A.ws;
    {
        LAS float* sc = (LAS float*)(lds + RING_OFF);
        LAS float* red = (LAS float*)(lds + RING_OFF + 65536);
        const float* c = A.in[1]; const float* w_ada = A.in[2]; const float* b_ada = A.in[3]; float* MOD = (float*)(ws + WS_MOD);
        for (int i = tid; i < BATCH * D; i += NTHR) { const float v = c[i]; sc[i] = v / (1.0f + __expf(-v)); }
        __syncthreads();
        for (int cw = bx; cw < 256; cw += G) {
            const int n0 = 24 * cw, kk = lane >> 3, cq = lane & 7;
            f32x4 wv[16];
#pragma unroll
            for (int i = 0; i < 16; ++i) { wv[i] = (f32x4){0.f, 0.f, 0.f, 0.f}; if (cq < 6) wv[i] = *(const f32x4*)(w_ada + (size_t)(128 * wave + 8 * i + kk) * (6 * D) + n0 + 4 * cq); }
#pragma unroll 1
            for (int b = 0; b < 16; ++b) { f32x4 a = {0.f, 0.f, 0.f, 0.f};
#pragma unroll
                for (int i = 0; i < 16; ++i) a += wv[i] * sc[b * D + 128 * wave + 8 * i + kk];
#pragma unroll
                for (int j = 0; j < 4; ++j) { float v = a[j]; v += __shfl_xor(v, 8); v += __shfl_xor(v, 16); v += __shfl_xor(v, 32); a[j] = v; }
                if (lane < 8) {
#pragma unroll
                    for (int j = 0; j < 4; ++j) red[(wave * 16 + b) * 32 + 4 * cq + j] = a[j]; } }
            __syncthreads();
            if (tid < 16 * 24) { const int b = tid / 24, col = tid % 24; float s = b_ada[n0 + col];
#pragma unroll
                for (int w = 0; w < 8; ++w) s += red[(w * 16 + b) * 32 + col];
                MOD[(size_t)b * (6 * D) + n0 + col] = s; }
            __syncthreads();
        }
    }
    const int gw = bx * NWAVES + wave, NGW = G * NWAVES;
    bf16* Win_t = (bf16*)(ws + WS_WIN); bf16* Wap_t = (bf16*)(ws + WS_WAP); bf16* Wsp_t = (bf16*)(ws + WS_WSP); bf16* Wout_t = (bf16*)(ws + WS_WOUT); bf16* Wgu_t = (bf16*)(ws + WS_WGU); bf16* Wd_t = (bf16*)(ws + WS_WD);
    constexpr int I_IN = 16 * 112, I_SQ = 16 * 16, I_GU = NEXP * 16 * 8, I_DN = NEXP * 4 * 16, NITEMS = I_IN + 3 * I_SQ + I_GU + I_DN;
    for (int it = gw; it < NITEMS; it += NGW) {
        int r = it; const float* W; bf16* WT; int N, Kd, k0, n0, dr;
        if (r < I_IN) { const int kb = r / 112, nb = r % 112; W = A.in[5]; N = NIN; WT = Win_t; Kd = D; k0 = 64 * kb; n0 = 64 * nb; dr = n0; }
        else if ((r -= I_IN) < 3 * I_SQ) { const int which = r / I_SQ, rr = r % I_SQ, kb = rr / 16, nb = rr % 16;
            W = which == 0 ? A.in[11] : (which == 1 ? A.in[16] : A.in[17]); WT = which == 0 ? Wap_t : (which == 1 ? Wsp_t : Wout_t); N = D; Kd = D; k0 = 64 * kb; n0 = 64 * nb; dr = n0; }
        else if ((r -= 3 * I_SQ) < I_GU) { const int e = r / 128, rr = r % 128, kb = rr / 8, nb = rr % 8, bj = (64 * nb) >> 8, wi = (64 * nb) & 255, j = wi >> 7, cc = wi & 127;
            W = A.in[23] + (size_t)e * D * 512; N = 512; WT = Wgu_t; Kd = D; k0 = 64 * kb; n0 = 64 * nb; dr = e * 512 + j * 256 + bj * 128 + cc; }
        else { r -= I_GU; const int e = r / 64, rr = r % 64, kb = rr / 16, nb = rr % 16;
            W = A.in[24] + (size_t)e * DEXP * D; N = D; WT = Wd_t; Kd = DEXP; k0 = 64 * kb; n0 = 64 * nb; dr = e * D + n0; }
        tr_item(W, N, WT, Kd, k0, n0, dr, lane);
    }
    { const float* wsrc = A.in[14]; unsigned* wdst = (unsigned*)(ws + WS_WSB);
        for (int i = bx * NTHR + tid; i < 8 * 128 * 128 / 2; i += G * NTHR) wdst[i] = pk2(wsrc[2 * i], wsrc[2 * i + 1]); }
}

__device__ __forceinline__ void p1_body(const Args& A, LAS unsigned char* lds, int tid, int lane, int wave, int bx, int G) {
    unsigned char* ws = A.ws;
    const float* MOD = (const float*)(ws + WS_MOD); const float* x = A.in[0]; const float* g1 = A.in[4]; bf16* H = (bf16*)(ws + WS_H);
    for (int rb = bx; rb < NRB; rb += G) {
        const int b = rb / 16; const float* mb = MOD + (size_t)b * (6 * D);
        f32x4 a1[4], s1[4];
#pragma unroll
        for (int j = 0; j < 4; ++j) { const int d = 4 * lane + 256 * j; const f32x4 gv = *(const f32x4*)(g1 + d), sv = *(const f32x4*)(mb + D + d); a1[j] = gv * (sv + 1.0f); s1[j] = *(const f32x4*)(mb + d); }
        for (int i = 0; i < 16; ++i) { const size_t t = (size_t)rb * 128 + wave * 16 + i;
            f32x4 v[4]; float ss = 0.f;
#pragma unroll
            for (int j = 0; j < 4; ++j) { v[j] = *(const f32x4*)(x + t * D + 4 * lane + 256 * j); ss += (v[j][0] * v[j][0] + v[j][1] * v[j][1]) + (v[j][2] * v[j][2] + v[j][3] * v[j][3]); }
            const float rstd = __builtin_amdgcn_rsqf(wave_sum(ss) * (1.0f / D) + EPS);
#pragma unroll
            for (int j = 0; j < 4; ++j) { const f32x4 h = v[j] * rstd * a1[j] + s1[j]; v2u o; o.x = pk2(h[0], h[1]); o.y = pk2(h[2], h[3]); *(v2u*)(H + t * D + 4 * lane + 256 * j) = o; }
        }
    }
    const float* g2 = A.in[18]; const float* w_rg = A.in[19]; const float* b_rg = A.in[20]; const float* w_re = A.in[21]; const float* b_re = A.in[22];
    float* WR = (float*)(ws + WS_WR); float* CB = (float*)(ws + WS_CB);
    LAS float* red = (LAS float*)(lds + RING_OFF);
    for (int item = bx; item < 256; item += G) { const int b = item / 16, part = item % 16; const float* mb = MOD + (size_t)b * (6 * D);
        for (int ee = 0; ee < 3; ++ee) { const int e = 3 * part + ee; float cp = 0.f;
            for (int d = tid; d < D; d += NTHR) { const float wr = e < 32 ? w_re[d * 32 + e] : (e < 36 ? w_rg[d * 4 + (e - 32)] : 0.f);
                WR[(((size_t)b * 256 + (d >> 2)) * 48 + e) * 4 + (d & 3)] = g2[d] * (1.0f + mb[4 * D + d]) * wr; cp += mb[3 * D + d] * wr; }
            cp = wave_sum(cp); if (lane == 0) red[wave] = cp;
            __syncthreads();
            if (tid == 0) { float s = e < 32 ? b_re[e] : (e < 36 ? b_rg[e - 32] : 0.f);
#pragma unroll
                for (int w = 0; w < 8; ++w) s += red[w];
                CB[b * 48 + e] = s; }
            __syncthreads(); }
    }
}

typedef float f32x4m __attribute__((ext_vector_type(4)));
__device__ __forceinline__ void p6a_body(const Args& A, LAS unsigned char* lds, int tid, int lane, int wave, int bx, int G) {
    unsigned char* ws = A.ws;
    const float* X1 = A.out; const float* WR = (const float*)(ws + WS_WR); const float* CB = (const float*)(ws + WS_CB);
    int* TOKE = (int*)(ws + WS_TOKE); float* TOKW0 = (float*)(ws + WS_TOKW0); float* TOKW1 = (float*)(ws + WS_TOKW1); float* TOKR = (float*)(ws + WS_TOKR); int* HIST = (int*)(ws + WS_HIST);
    LAS int* hist = (LAS int*)(lds + RING_OFF);
    LAS float* lg = (LAS float*)(lds + RING_OFF + 1024) + wave * (16 * 48);
    for (int rb = bx; rb < NRB; rb += G) {
        if (tid < 32) hist[tid] = 0;
        __syncthreads();
        const int b = rb / 16, row = lane & 15, kq = lane >> 4; const size_t t0 = (size_t)rb * 128 + wave * 16;
        const float* xp = X1 + (t0 + row) * D + 4 * kq;
        LAS f32x4* wl = (LAS f32x4*)(lds + RING_OFF + 32768);
        f32x4m acc0 = {0.f, 0.f, 0.f, 0.f}, acc1 = acc0, acc2 = acc0; float ss = 0.f;
        for (int half = 0; half < 2; ++half) {
            __syncthreads();
            { const f32x4* src = (const f32x4*)(WR + ((size_t)b * 256 + half * 128) * 48 * 4);
#pragma unroll
              for (int i = 0; i < 12; ++i) wl[tid + NTHR * i] = src[tid + NTHR * i]; }
            __syncthreads();
#pragma unroll 4
            for (int j = 0; j < 32; ++j) {
                const f32x4 xa = *(const f32x4*)(xp + half * 512 + 16 * j);
                const LAS f32x4* wq = wl + (4 * j + kq) * 48 + row;
                const f32x4 w0 = wq[0], w1 = wq[16], w2 = wq[32];
                ss += (xa[0] * xa[0] + xa[1] * xa[1]) + (xa[2] * xa[2] + xa[3] * xa[3]);
#pragma unroll
                for (int i = 0; i < 4; ++i) { acc0 = __builtin_amdgcn_mfma_f32_16x16x4f32(xa[i], w0[i], acc0, 0, 0, 0); acc1 = __builtin_amdgcn_mfma_f32_16x16x4f32(xa[i], w1[i], acc1, 0, 0, 0); acc2 = __builtin_amdgcn_mfma_f32_16x16x4f32(xa[i], w2[i], acc2, 0, 0, 0); }
            }
        }
        ss += __shfl_xor(ss, 16); ss += __shfl_xor(ss, 32);
        const float rstd = __builtin_amdgcn_rsqf(ss * (1.0f / D) + EPS);
#pragma unroll
        for (int i = 0; i < 4; ++i) { const int r = 4 * kq + i; lg[r * 48 + row] = acc0[i]; lg[r * 48 + 16 + row] = acc1[i]; lg[r * 48 + 32 + row] = acc2[i]; }
        LDS_WAIT(); asm volatile("" ::: "memory");
        if (lane < 16) {
            const LAS float* lp = lg + lane * 48; const float* cb = CB + b * 48;
            float gl[4];
#pragma unroll
            for (int i = 0; i < 4; ++i) gl[i] = rstd * lp[32 + i] + cb[32 + i];
            int gi = 0; float gm = gl[0];
#pragma unroll
            for (int i = 1; i < 4; ++i) if (gl[i] > gm) { gm = gl[i]; gi = i; }
            float gs = 0.f;
#pragma unroll
            for (int i = 0; i < 4; ++i) gs += __expf(gl[i] - gm);
            const float gval = 1.0f / gs;
            float el[8];
#pragma unroll
            for (int i = 0; i < 8; ++i) el[i] = rstd * lp[8 * gi + i] + cb[8 * gi + i];
            int e0 = 0; float m0 = el[0];
#pragma unroll
            for (int i = 1; i < 8; ++i) if (el[i] > m0) { m0 = el[i]; e0 = i; }
            int e1 = -1; float m1 = -3.0e38f;
#pragma unroll
            for (int i = 0; i < 8; ++i) if (i != e0 && el[i] > m1) { m1 = el[i]; e1 = i; }
            const float a1 = __expf(m1 - m0), inv = gval / (1.0f + a1);
            const size_t t = t0 + lane; const int ge0 = 8 * gi + e0, ge1 = 8 * gi + e1;
            TOKE[t] = ge0 | (ge1 << 8); TOKW0[t] = inv; TOKW1[t] = inv * a1; TOKR[t] = rstd;
            __hip_atomic_fetch_add(hist + ge0, 1, __ATOMIC_RELAXED, __HIP_MEMORY_SCOPE_WORKGROUP); __hip_atomic_fetch_add(hist + ge1, 1, __ATOMIC_RELAXED, __HIP_MEMORY_SCOPE_WORKGROUP);
        }
        __syncthreads();
        if (tid < 32) HIST[rb * 32 + tid] = hist[tid];
        __syncthreads();
    }
}

__device__ __forceinline__ void moe_table(const int* HIST, int rb, LAS unsigned char* lds, int tid) {
    LAS int* sc = (LAS int*)(lds + RING_OFF + 65536);
    LAS int* ebase = (LAS int*)(lds + LT_EBASE); LAS int* bef = (LAS int*)(lds + LT_BEF); LAS int* ntl = (LAS int*)(lds + LT_NT); LAS int* tbl = (LAS int*)(lds + LT_TBL);
    { const int e = tid & 31, part = tid >> 5; int st = 0, sb = 0;
        for (int j = 0; j < 16; ++j) { const int r = part * 16 + j; const int v = HIST[r * 32 + e]; st += v; sb += (r < rb) ? v : 0; }
        sc[part * 32 + e] = st; sc[512 + part * 32 + e] = sb; }
    __syncthreads();
    if (tid < 32) { int tot = 0, b = 0;
        for (int p = 0; p < 16; ++p) { tot += sc[p * 32 + tid]; b += sc[512 + p * 32 + tid]; }
        bef[tid] = b; sc[1024 + tid] = tot; }
    __syncthreads();
    if (tid == 0) { int base = 0, nt = 0;
        for (int e = 0; e < NEXP; ++e) { ebase[e] = base; const int n = (sc[1024 + e] + 255) >> 8; for (int k = 0; k < n; ++k) tbl[nt + k] = e; nt += n; base += n * 256; }
        ebase[NEXP] = base; *ntl = nt; }
    __syncthreads();
}

__device__ __forceinline__ void p6b_body(const Args& A, LAS unsigned char* lds, int tid, int lane, int wave, int bx, int G) {
    unsigned char* ws = A.ws;
    const float* X1 = A.out; const float* MOD = (const float*)(ws + WS_MOD); const float* g2 = A.in[18];
    const int* TOKE = (const int*)(ws + WS_TOKE); const float* TOKR = (const float*)(ws + WS_TOKR); int* SLOT0 = (int*)(ws + WS_SLOT0); int* SLOT1 = (int*)(ws + WS_SLOT1); const int* HIST = (const int*)(ws + WS_HIST);
    bf16* H2S = (bf16*)(ws + WS_H2S);
    LAS int* te = (LAS int*)(lds + RING_OFF); LAS int* sl = (LAS int*)(lds + RING_OFF + 1024);
    LAS int* ebase = (LAS int*)(lds + LT_EBASE); LAS int* bef = (LAS int*)(lds + LT_BEF);
    for (int rb = bx; rb < NRB; rb += G) {
        moe_table(HIST, rb, lds, tid);
        if (tid < 128) te[tid] = TOKE[rb * 128 + tid];
        __syncthreads();
        if (tid < 128) { const int me = te[tid], e0 = me & 255, e1 = me >> 8; int r0 = 0, r1 = 0;
            for (int j = 0; j < tid; ++j) { const int o = te[j], a = o & 255, c = o >> 8; r0 += (a == e0) + (c == e0); r1 += (a == e1) + (c == e1); }
            const int s0 = ebase[e0] + bef[e0] + r0, s1 = ebase[e1] + bef[e1] + r1;
            SLOT0[rb * 128 + tid] = s0; SLOT1[rb * 128 + tid] = s1; sl[2 * tid] = s0; sl[2 * tid + 1] = s1; }
        __syncthreads();
        const int b = rb / 16; const float* mb = MOD + (size_t)b * (6 * D);
        f32x4 a2[4], s2[4];
#pragma unroll
        for (int j = 0; j < 4; ++j) { const int d = 4 * lane + 256 * j; const f32x4 gv = *(const f32x4*)(g2 + d), sv = *(const f32x4*)(mb + 4 * D + d); a2[j] = gv * (sv + 1.0f); s2[j] = *(const f32x4*)(mb + 3 * D + d); }
        for (int i0 = 0; i0 < 16; i0 += 4) {
            f32x4 v[4][4]; float rstd[4]; size_t o0[4], o1[4];
#pragma unroll
            for (int u = 0; u < 4; ++u) { const int row = wave * 16 + i0 + u; const size_t t = (size_t)rb * 128 + row;
                rstd[u] = TOKR[t]; o0[u] = (size_t)sl[2 * row] * D; o1[u] = (size_t)sl[2 * row + 1] * D;
#pragma unroll
                for (int j = 0; j < 4; ++j) v[u][j] = *(const f32x4*)(X1 + t * D + 4 * lane + 256 * j); }
#pragma unroll
            for (int u = 0; u < 4; ++u)
#pragma unroll
                for (int j = 0; j < 4; ++j) { const f32x4 h = v[u][j] * rstd[u] * a2[j] + s2[j];
                    v2u o; o.x = pk2(h[0], h[1]); o.y = pk2(h[2], h[3]); *(v2u*)(H2S + o0[u] + 4 * lane + 256 * j) = o; *(v2u*)(H2S + o1[u] + 4 * lane + 256 * j) = o; }
        }
        __syncthreads();
    }
}

__device__ __forceinline__ void p8_body(const Args& A, int tid, int lane, int wave, int bx, int G) {
    unsigned char* ws = A.ws;
    float* X1 = A.out; const float* MOD = (const float*)(ws + WS_MOD); const float* fg = A.in[25];
    const float* TOKW0 = (const float*)(ws + WS_TOKW0); const float* TOKW1 = (const float*)(ws + WS_TOKW1); const int* SLOT0 = (const int*)(ws + WS_SLOT0); const int* SLOT1 = (const int*)(ws + WS_SLOT1);
    const bf16* EO = (const bf16*)(ws + WS_EO);
    for (int rb = bx; rb < NRB; rb += G) {
        const int b = rb / 16; const float* mb = MOD + (size_t)b * (6 * D);
        f32x4 gt[4], fgv[4];
#pragma unroll
        for (int j = 0; j < 4; ++j) { const int d = 4 * lane + 256 * j; gt[j] = *(const f32x4*)(mb + 5 * D + d); fgv[j] = *(const f32x4*)(fg + d); }
        for (int i0 = 0; i0 < 16; i0 += 4) {
            f32x4 xv[4][4]; v2u ea[4][4], eb[4][4]; float w0[4], w1[4];
#pragma unroll
            for (int u = 0; u < 4; ++u) { const size_t t = (size_t)rb * 128 + wave * 16 + i0 + u;
                w0[u] = TOKW0[t]; w1[u] = TOKW1[t]; const size_t o0 = (size_t)SLOT0[t] * D, o1 = (size_t)SLOT1[t] * D;
#pragma unroll
                for (int j = 0; j < 4; ++j) { const int d = 4 * lane + 256 * j; xv[u][j] = *(const f32x4*)(X1 + t * D + d); ea[u][j] = *(const v2u*)(EO + o0 + d); eb[u][j] = *(const v2u*)(EO + o1 + d); } }
#pragma unroll
            for (int u = 0; u < 4; ++u) { const size_t t = (size_t)rb * 128 + wave * 16 + i0 + u; float ss = 0.f; f32x4 v[4];
#pragma unroll
                for (int j = 0; j < 4; ++j) { const v2u a = ea[u][j], c = eb[u][j];
                    const f32x4 y = {w0[u] * pg8::bf_lo(a.x) + w1[u] * pg8::bf_lo(c.x), w0[u] * pg8::bf_hi(a.x) + w1[u] * pg8::bf_hi(c.x), w0[u] * pg8::bf_lo(a.y) + w1[u] * pg8::bf_lo(c.y), w0[u] * pg8::bf_hi(a.y) + w1[u] * pg8::bf_hi(c.y)};
                    v[j] = xv[u][j] + gt[j] * y; ss += (v[j][0] * v[j][0] + v[j][1] * v[j][1]) + (v[j][2] * v[j][2] + v[j][3] * v[j][3]); }
                const float rstd = __builtin_amdgcn_rsqf(wave_sum(ss) * (1.0f / D) + EPS);
#pragma unroll
                for (int j = 0; j < 4; ++j) *(f32x4*)(X1 + t * D + 4 * lane + 256 * j) = v[j] * rstd * fgv[j]; }
        }
    }
}

template <class Base> struct RepOrder : Base {
    int ni, rep;
    __device__ __forceinline__ void setup(int rep_) { rep = rep_; ni = 0; pg8::Unit t; while (Base::next(ni, t)) ++ni; }
    __device__ __forceinline__ bool next(int i, pg8::Unit& u) const { if (i >= ni * rep) return false; return Base::next(i % ni, u); }
};
__global__ void __launch_bounds__(NTHR, 2) fwd(Args args) {
    extern __shared__ __attribute__((aligned(16))) unsigned char lds_raw[];
    LAS unsigned char* lds = (LAS unsigned char*)lds_raw;
    const int tid = threadIdx.x, lane = tid & 63, wave = __builtin_amdgcn_readfirstlane(tid >> 6);
    const int G = gridDim.x, bx = blockIdx.x, vcu = (G % 8 == 0) ? (bx % 8) * (G / 8) + bx / 8 : bx;
    unsigned char* ws = args.ws;
    gu32* ctl = (gu32*)(ws + WS_CTL);
    volatile LAS unsigned* MISC = (volatile LAS unsigned*)(lds + MISC_OFF);
    for (int u = tid; u < (LDS_BYTES - LDSCTL_OFF) / 4; u += NTHR) ((LAS unsigned*)(lds + LDSCTL_OFF))[u] = 0u;
    __syncthreads();
    XcdBarrier bar = xcd_barrier_post((unsigned*)(ctl + CW_BAR) + args.li * XCD_BAR_WORDS, MISC + 8);
    const int lo = args.ph_lo, hi = args.ph_hi;
#ifndef PH_MASK
#define PH_MASK 0x7ff
#endif
#define IN(k) ((((PH_MASK) >> (k)) & 1) && lo <= (k) && (k) < hi)
#ifndef REP_MASK
#define REP_MASK 0
#endif
#define NREP(k) ((((REP_MASK) >> (k)) & 1) ? 2 : 1)
#if REP_MASK
#define ORD(T_) RepOrder<T_>
#define ORD_SETUP(S_, k) (S_).setup(NREP(k))
#else
#define ORD(T_) T_
#define ORD_SETUP(S_, k) do {} while (0)
#endif
#define SEAM(k) do { if (IN(k) && IN((k) + 1)) xcd_barrier(bar); } while (0)
    bf16* Hb = (bf16*)(ws + WS_H); bf16* Qb = (bf16*)(ws + WS_Q); bf16* Kb = (bf16*)(ws + WS_K); bf16* Vb = (bf16*)(ws + WS_V); bf16* Ub = (bf16*)(ws + WS_U); bf16* Sb = (bf16*)(ws + WS_S);
    bf16* GAb = (bf16*)args.out; bf16* GBb = GAb + (size_t)T * D; bf16* Yb = (bf16*)(ws + WS_Y); bf16* ATb = (bf16*)(ws + WS_ATT);
    const float* MOD = (const float*)(ws + WS_MOD);

    volatile LAS unsigned* tacc = (volatile LAS unsigned*)(lds + MISC_OFF + 64);
    if (IN(0)) { for (int rep = 0; rep < NREP(0); ++rep) p0_body(args, lds, tid, lane, wave, bx, G); } SEAM(0);
    if (IN(1)) { for (int rep = 0; rep < NREP(1); ++rep) p1_body(args, lds, tid, lane, wave, bx, G); } SEAM(1);
    if (IN(2)) {
        pg8::Gemm g{Hb, (const bf16*)(ws + WS_WIN), T, NIN, D}; ORD(pg8::StaticOrder) S; S.init(T, NIN, G, bx); ORD_SETUP(S, 2);
        pg8::EpiIn E{Qb, GAb, (size_t)T * D, 0.125f * 1.4426950408889634f, (unsigned*)(ws + WS_KN2)};
#if ATT_ECHO == 7
        const unsigned long long tg0 = __builtin_amdgcn_s_memtime();
#endif
        pg8::gemm_phase<pg8::EpiIn, ORD(pg8::StaticOrder), true, true>(lds + RING_OFF, g, S, E);
#if ATT_ECHO == 7
        if (bx == 0 && tid == 0) *tacc += (unsigned)(__builtin_amdgcn_s_memtime() - tg0);
#endif
    } SEAM(2);
    if (IN(3)) {
        float lam;
        { const float a = args.in[6][lane] * args.in[7][lane], c = args.in[8][lane] * args.in[9][lane]; lam = __expf(wave_sum(a)) - __expf(wave_sum(c)) + 0.2f; }
        for (int rep = 0; rep < NREP(3); ++rep)
        for (int i = 0;; ++i) { const int U = i * G + vcu; if (U >= BATCH * 8 * 16) break;
            const int r_ = U >> 8, g_ = (U >> 4) & 15, b = 2 * r_ + (g_ >> 3), h = ((g_ & 7) + r_) & 7, qb = ((U & 15) + 4 * r_) & 15;
            const float slope2 = __builtin_amdgcn_exp2f(-(float)(h + 1)) * 1.4426950408889634f;
            att::attn_unit(b, h, qb, Qb, Kb, Vb, ATb, (char*)lds_raw + RING_OFF, lam, slope2, args.in[10], 0.8f, tacc, (const unsigned*)(ws + WS_KN2)); }
        for (int u = vcu; u < NRB; u += G)
            att::sgu_unit(u >> 4, u & 15, Sb, Ub, (const bf16*)(ws + WS_WSB), args.in[15], args.in[12], args.in[13], (char*)lds_raw + RING_OFF);
    } SEAM(3);
    if (IN(4)) {
        ORD(pg8::StaticOrder) S; S.init(T, D, G, bx); ORD_SETUP(S, 4);
        { pg8::Gemm g{ATb, (const bf16*)(ws + WS_WAP), T, D, D}; pg8::EpiGate<true> E{GAb, Yb};
          pg8::gemm_phase<pg8::EpiGate<true>, ORD(pg8::StaticOrder), true, true>(lds + RING_OFF, g, S, E); }
        VM_WAIT(); __syncthreads();
        { pg8::Gemm g{Ub, (const bf16*)(ws + WS_WSP), T, D, D}; pg8::EpiGate<false> E{GBb, Yb};
          pg8::gemm_phase<pg8::EpiGate<false>, ORD(pg8::StaticOrder), true, true>(lds + RING_OFF, g, S, E); }
    } SEAM(4);
    if (IN(5)) {
        pg8::Gemm g{Yb, (const bf16*)(ws + WS_WOUT), T, D, D}; ORD(pg8::StaticOrder) S; S.init(T, D, G, bx); ORD_SETUP(S, 5);
        pg8::EpiRes E{args.in[0], args.out, MOD + 2 * D, 6 * D, SEQ};
        pg8::gemm_phase<pg8::EpiRes, ORD(pg8::StaticOrder), true, true>(lds + RING_OFF, g, S, E);
    } SEAM(5);
    if (IN(6)) { for (int rep = 0; rep < NREP(6); ++rep) p6a_body(args, lds, tid, lane, wave, bx, G); } SEAM(6);
    if (IN(7)) { for (int rep = 0; rep < NREP(7); ++rep) p6b_body(args, lds, tid, lane, wave, bx, G); } SEAM(7);
    if (IN(8)) {
        moe_table((const int*)(ws + WS_HIST), 0, lds, tid);
        pg8::Gemm g{(const bf16*)(ws + WS_H2S), (const bf16*)(ws + WS_WGU), 0, 0, D};
        ORD(pg8::MoeOrder<2>) S; S.tbl = (const volatile LAS int*)(lds + LT_TBL); S.ntiles = *(volatile LAS int*)(lds + LT_NT); S.G = G; S.c = vcu; ORD_SETUP(S, 8);
        pg8::EpiGU E{(bf16*)(ws + WS_ACT)};
        pg8::gemm_phase<pg8::EpiGU, ORD(pg8::MoeOrder<2>), true, true>(lds + RING_OFF, g, S, E);
    } SEAM(8);
    if (IN(9)) {
        moe_table((const int*)(ws + WS_HIST), 0, lds, tid);
        int kdn = DEXP; asm volatile("" : "+s"(kdn));
        pg8::Gemm g{(const bf16*)(ws + WS_ACT), (const bf16*)(ws + WS_WD), 0, 0, kdn};
        ORD(pg8::MoeOrder<4>) S; S.tbl = (const volatile LAS int*)(lds + LT_TBL); S.ntiles = *(volatile LAS int*)(lds + LT_NT); S.G = G; S.c = vcu; ORD_SETUP(S, 9);
        pg8::EpiDown E{(bf16*)(ws + WS_EO)};
        pg8::gemm_phase<pg8::EpiDown, ORD(pg8::MoeOrder<4>), true, true>(lds + RING_OFF, g, S, E);
    } SEAM(9);
    if (IN(10)) { p8_body(args, tid, lane, wave, bx, G); }
#if ATT_ECHO
    __syncthreads(); { const unsigned tw = *tacc; if (tw) { const unsigned long long ts = __builtin_amdgcn_s_memtime(); while (__builtin_amdgcn_s_memtime() - ts < (unsigned long long)tw) __builtin_amdgcn_s_sleep(8); } }
#endif
#undef IN
#undef SEAM
}

extern "C" void kernel_launch(void* const* d_in, const int* in_sizes, int n_in, void* d_out, int out_size, void* d_ws, size_t ws_size, hipStream_t stream) {
    static int grid = 0;
    if (grid == 0) {
        if (n_in != 26 || in_sizes[0] != T * D || out_size != T * D || ws_size < WS_END) { fprintf(stderr, "kernel_launch: unexpected shapes (n_in %d, in0 %d, out %d, ws %zu); nothing launched\n", n_in, n_in > 0 ? in_sizes[0] : -1, out_size, ws_size); grid = -1; return; }
        int dev = 0, cus = 0, per_cu = 0;
        if (hipGetDevice(&dev) != hipSuccess || hipDeviceGetAttribute(&cus, hipDeviceAttributeMultiprocessorCount, dev) != hipSuccess) { grid = -1; return; }
        if (hipFuncSetAttribute((const void*)fwd, hipFuncAttributeMaxDynamicSharedMemorySize, LDS_BYTES) != hipSuccess) { fprintf(stderr, "kernel_launch: hipFuncSetAttribute failed\n"); grid = -1; return; }
        if (hipOccupancyMaxActiveBlocksPerMultiprocessor(&per_cu, (const void*)fwd, NTHR, LDS_BYTES) != hipSuccess || per_cu < 1) { fprintf(stderr, "kernel_launch: occupancy query reports %d workgroups per CU\n", per_cu); }
        (void)hipGetLastError();
        grid = cus;
    }
    if (grid < 0) return;
    (void)hipMemsetAsync((char*)d_ws + WS_CTL, 0, CTL_ZERO_BYTES, stream);
    Args a{};
    for (int i = 0; i < 26; ++i) a.in[i] = (const float*)d_in[i];
    a.out = (float*)d_out; a.ws = (unsigned char*)d_ws; a.pad = 0;
    if (N_LAUNCHES == 1) { a.ph_lo = 0; a.ph_hi = N_PHASES; a.li = 0; hipLaunchKernelGGL(fwd, dim3(grid), dim3(NTHR), LDS_BYTES, stream, a); }
    else { for (int li = 0; li < N_PHASES; ++li) { a.ph_lo = li; a.ph_hi = li + 1; a.li = li; hipLaunchKernelGGL(fwd, dim3(grid), dim3(NTHR), LDS_BYTES, stream, a); } }
}
```
